# Optimizing an MI355X kernel written in HIP

```python
import math
import jax, jax.numpy as jnp
from jax import lax
import numpy as np

D_MODEL = 2048
BATCH = 1
SEQ = 8192
DEPTH = 1
DEC_BATCH = 1
DEC_SEQ = 16384
PAST_LEN = 128

DA_HEADS = 8
DA_QK_DIM = 64
DA_V_DIM = 2 * DA_QK_DIM
DA_ROT_DIM = DA_QK_DIM // 4
MLA_HEADS = 8
MLA_Q_RANK = 512
MLA_KV_RANK = 512
MLA_NOPE_DIM = 128
MLA_ROPE_DIM = 64
MLA_V_DIM = 128
ROPE_THETA = 500000.0
Q_BLOCK = 128
NORM_EPS = 1e-6
FFN_HIDDEN = -(-8 * D_MODEL // (3 * 256)) * 256
DA_Q_COLS = DA_HEADS * 2 * DA_QK_DIM
DA_K_COLS = DA_HEADS * 2 * DA_QK_DIM
DA_V_COLS = DA_HEADS * DA_V_DIM
GATE_COLS = 2 * D_MODEL
IN_COLS = DA_Q_COLS + DA_K_COLS + DA_V_COLS + MLA_Q_RANK + MLA_KV_RANK + MLA_ROPE_DIM + GATE_COLS
DA_OUT = DA_HEADS * DA_V_DIM
MLA_OUT = MLA_HEADS * MLA_V_DIM

kernel_name = "hybrid_diffattn_mla_gated_encoder"


def rmsnorm(x, g):
    xf = x.astype(jnp.float32)
    y = xf * lax.rsqrt(jnp.mean(xf * xf, axis=-1, keepdims=True) + NORM_EPS)
    return (y * g.astype(jnp.float32)).astype(x.dtype)


def rope(x, rot_dim):
    s = x.shape[1]
    pos = jnp.arange(s, dtype=jnp.float32)
    inv_freq = ROPE_THETA ** (-jnp.arange(0, rot_dim, 2, dtype=jnp.float32) / rot_dim)
    ang = pos[:, None] * inv_freq[None, :]
    ang = ang.reshape((s,) + (1,) * (x.ndim - 3) + (rot_dim // 2,))
    cos, sin = jnp.cos(ang), jnp.sin(ang)
    xr = x[..., :rot_dim].astype(jnp.float32)
    x1, x2 = xr[..., : rot_dim // 2], xr[..., rot_dim // 2:]
    rot = jnp.concatenate([x1 * cos - x2 * sin, x2 * cos + x1 * sin], axis=-1).astype(x.dtype)
    return jnp.concatenate([rot, x[..., rot_dim:]], axis=-1)


def to_blocks(t):
    b, s = t.shape[:2]
    return jnp.moveaxis(t.reshape((b, s // Q_BLOCK, Q_BLOCK) + t.shape[2:]), 1, 0)


def from_blocks(t):
    t = jnp.moveaxis(t, 0, 1)
    return t.reshape((t.shape[0], t.shape[1] * t.shape[2]) + t.shape[3:])


def softmax_f32(s, scale):
    return jax.nn.softmax(s.astype(jnp.float32) * scale, axis=-1)


def diff_attention(q, k, v, lam, subln_g, lambda_init):
    b, s = q.shape[:2]
    scale = DA_QK_DIM ** -0.5
    k1, k2 = k[..., 0, :], k[..., 1, :]

    def block(qb):
        a1 = softmax_f32(jnp.einsum('bqhd,bkhd->bhqk', qb[..., 0, :], k1), scale)
        a2 = softmax_f32(jnp.einsum('bqhd,bkhd->bhqk', qb[..., 1, :], k2), scale)
        a = (a1 - lam * a2).astype(v.dtype)
        return jnp.einsum('bhqk,bkhd->bqhd', a, v)

    o = from_blocks(lax.map(block, to_blocks(q)))
    o = rmsnorm(o, subln_g) * (1.0 - lambda_init)
    return o.reshape(b, s, DA_OUT)


def mla_attention(c_q, c_kv, k_rope, q_norm_g, w_q_b, kv_norm_g, w_kv_b):
    b, s = c_q.shape[:2]
    q = (rmsnorm(c_q, q_norm_g) @ w_q_b).reshape(b, s, MLA_HEADS, MLA_NOPE_DIM + MLA_ROPE_DIM)
    q_nope, q_rope = q[..., :MLA_NOPE_DIM], rope(q[..., MLA_NOPE_DIM:], MLA_ROPE_DIM)
    kv = (rmsnorm(c_kv, kv_norm_g) @ w_kv_b).reshape(b, s, MLA_HEADS, MLA_NOPE_DIM + MLA_V_DIM)
    k_nope, v = kv[..., :MLA_NOPE_DIM], kv[..., MLA_NOPE_DIM:]
    k_r = rope(k_rope[:, :, None, :], MLA_ROPE_DIM)[:, :, 0, :]
    scale = (MLA_NOPE_DIM + MLA_ROPE_DIM) ** -0.5

    def block(qs):
        qn, qr = qs
        sc = jnp.einsum('bqhd,bkhd->bhqk', qn, k_nope) + jnp.einsum('bqhd,bkd->bhqk', qr, k_r)
        p = softmax_f32(sc, scale).astype(v.dtype)
        return jnp.einsum('bhqk,bkhd->bqhd', p, v)

    o = from_blocks(lax.map(block, (to_blocks(q_nope), to_blocks(q_rope))))
    return o.reshape(b, s, MLA_OUT)


def encoder_layer(x, lambda_init, attn_norm_g, w_in, da_lambda_q1, da_lambda_k1, da_lambda_q2,
                  da_lambda_k2, da_subln_g, mla_q_norm_g, mla_w_q_b, mla_kv_norm_g, mla_w_kv_b,
                  w_branch_da, w_branch_mla, w_out, ffn_norm_g, w_gate, w_up, w_down):
    b, s, _ = x.shape
    h = rmsnorm(x, attn_norm_g)
    proj = h @ w_in
    cuts = np.cumsum([DA_Q_COLS, DA_K_COLS, DA_V_COLS, MLA_Q_RANK, MLA_KV_RANK, MLA_ROPE_DIM]).tolist()
    q_da, k_da, v_da, c_q, c_kv, k_rope, gate_logits = jnp.split(proj, cuts, axis=-1)
    q_da = rope(q_da.reshape(b, s, DA_HEADS, 2, DA_QK_DIM), DA_ROT_DIM)
    k_da = rope(k_da.reshape(b, s, DA_HEADS, 2, DA_QK_DIM), DA_ROT_DIM)
    v_da = v_da.reshape(b, s, DA_HEADS, DA_V_DIM)
    lam = (jnp.exp(jnp.sum(da_lambda_q1.astype(jnp.float32) * da_lambda_k1.astype(jnp.float32)))
           - jnp.exp(jnp.sum(da_lambda_q2.astype(jnp.float32) * da_lambda_k2.astype(jnp.float32)))
           + lambda_init)
    o_da = diff_attention(q_da, k_da, v_da, lam, da_subln_g, lambda_init)
    o_mla = mla_attention(c_q, c_kv, k_rope, mla_q_norm_g, mla_w_q_b, mla_kv_norm_g, mla_w_kv_b)
    gates = jax.nn.sigmoid(gate_logits.astype(jnp.float32)).astype(x.dtype)
    g_da, g_mla = gates[..., :D_MODEL], gates[..., D_MODEL:]
    merged = g_da * (o_da @ w_branch_da) + g_mla * (o_mla @ w_branch_mla)
    x = x + merged @ w_out
    h = rmsnorm(x, ffn_norm_g)
    x = x + (jax.nn.silu(h @ w_gate) * (h @ w_up)) @ w_down
    return x


def trunk(x, attn_norm_g, w_in, da_lambda_q1, da_lambda_k1, da_lambda_q2, da_lambda_k2, da_subln_g,
          mla_q_norm_g, mla_w_q_b, mla_kv_norm_g, mla_w_kv_b, w_branch_da, w_branch_mla, w_out,
          ffn_norm_g, w_gate, w_up, w_down, final_norm_g):
    for l in range(DEPTH):
        lambda_init = 0.8 - 0.6 * math.exp(-0.3 * l)
        x = encoder_layer(x, lambda_init, attn_norm_g[l], w_in[l], da_lambda_q1[l], da_lambda_k1[l],
                          da_lambda_q2[l], da_lambda_k2[l], da_subln_g[l], mla_q_norm_g[l], mla_w_q_b[l],
                          mla_kv_norm_g[l], mla_w_kv_b[l], w_branch_da[l], w_branch_mla[l], w_out[l],
                          ffn_norm_g[l], w_gate[l], w_up[l], w_down[l])
    return rmsnorm(x, final_norm_g)


def setup_inputs(seed: int = 0) -> dict:
    key = jax.random.key(seed)
    ks = jax.random.split(key, 24)

    def w(k, shape, fan_in):
        return jax.random.normal(k, shape, jnp.float32) * fan_in ** -0.5

    def gain(k, shape):
        return 1.0 + 0.02 * jax.random.normal(k, shape, jnp.float32)

    def lam(k):
        return 0.1 * jax.random.normal(k, (DEPTH, DA_QK_DIM), jnp.float32)

    return {
        "x_prompt": jax.random.normal(ks[0], (BATCH, SEQ, D_MODEL), jnp.float32),
        "x_sample": jax.random.normal(ks[1], (DEC_BATCH, DEC_SEQ, D_MODEL), jnp.float32),
        "attn_norm_g": gain(ks[2], (DEPTH, D_MODEL)),
        "w_in": w(ks[3], (DEPTH, D_MODEL, IN_COLS), D_MODEL),
        "da_lambda_q1": lam(ks[4]),
        "da_lambda_k1": lam(ks[5]),
        "da_lambda_q2": lam(ks[6]),
        "da_lambda_k2": lam(ks[7]),
        "da_subln_g": gain(ks[8], (DEPTH, DA_V_DIM)),
        "mla_q_norm_g": gain(ks[9], (DEPTH, MLA_Q_RANK)),
        "mla_w_q_b": w(ks[10], (DEPTH, MLA_Q_RANK, MLA_HEADS * (MLA_NOPE_DIM + MLA_ROPE_DIM)), MLA_Q_RANK),
        "mla_kv_norm_g": gain(ks[11], (DEPTH, MLA_KV_RANK)),
        "mla_w_kv_b": w(ks[12], (DEPTH, MLA_KV_RANK, MLA_HEADS * (MLA_NOPE_DIM + MLA_V_DIM)), MLA_KV_RANK),
        "w_branch_da": w(ks[13], (DEPTH, DA_OUT, D_MODEL), DA_OUT),
        "w_branch_mla": w(ks[14], (DEPTH, MLA_OUT, D_MODEL), MLA_OUT),
        "w_out": w(ks[15], (DEPTH, D_MODEL, D_MODEL), D_MODEL),
        "ffn_norm_g": gain(ks[16], (DEPTH, D_MODEL)),
        "w_gate": w(ks[17], (DEPTH, D_MODEL, FFN_HIDDEN), D_MODEL),
        "w_up": w(ks[18], (DEPTH, D_MODEL, FFN_HIDDEN), D_MODEL),
        "w_down": w(ks[19], (DEPTH, FFN_HIDDEN, D_MODEL), FFN_HIDDEN),
        "final_norm_g": gain(ks[20], (D_MODEL,)),
    }


def reference(x_prompt, x_sample, attn_norm_g, w_in, da_lambda_q1, da_lambda_k1, da_lambda_q2,
              da_lambda_k2, da_subln_g, mla_q_norm_g, mla_w_q_b, mla_kv_norm_g, mla_w_kv_b,
              w_branch_da, w_branch_mla, w_out, ffn_norm_g, w_gate, w_up, w_down, final_norm_g):
    params = (attn_norm_g, w_in, da_lambda_q1, da_lambda_k1, da_lambda_q2, da_lambda_k2, da_subln_g,
              mla_q_norm_g, mla_w_q_b, mla_kv_norm_g, mla_w_kv_b, w_branch_da, w_branch_mla, w_out,
              ffn_norm_g, w_gate, w_up, w_down, final_norm_g)
    y_prompt = trunk(x_prompt, *params)
    y_sample = trunk(x_sample, *params)
    return (y_prompt, y_sample)
```

```cpp
#include <hip/hip_runtime.h>
#include <hip/hip_cooperative_groups.h>
#include <cstdio>
#include <cstdint>
namespace cg = cooperative_groups;

#define LAS __attribute__((address_space(3)))
typedef unsigned short bf16_t;
typedef short bf16x8 __attribute__((ext_vector_type(8)));
typedef short s16x4 __attribute__((ext_vector_type(4)));
typedef float f32x4 __attribute__((ext_vector_type(4)));
typedef float f32x16 __attribute__((ext_vector_type(16)));
typedef unsigned u32x4 __attribute__((ext_vector_type(4)));
typedef unsigned u32x2 __attribute__((ext_vector_type(2)));

constexpr int DM = 2048, S0 = 8192, S1 = 16384, T = S0 + S1;
constexpr int FF = 5632;
constexpr float EPS = 1e-6f;
constexpr float LOG2E = 1.4426950408889634f;

constexpr size_t MiB = 1u << 20;
constexpr size_t WS_SSQ = 0;
constexpr size_t WS_BAR = 2 * MiB;
constexpr size_t WS_RSTD = 2 * MiB + 256 * 1024;
constexpr size_t WS_TDA = 3 * MiB;
constexpr size_t WS_TMLA = 4 * MiB;
constexpr size_t WS_WI = 8 * MiB;
constexpr size_t WS_WG = 25 * MiB;
constexpr size_t WS_WQB = 41 * MiB;
constexpr size_t WS_WKVB = WS_WQB + 3 * MiB / 2;
constexpr size_t WS_WBDA = WS_WKVB + 2 * MiB;
constexpr size_t WS_WBMLA = WS_WBDA + 4 * MiB;
constexpr size_t WS_QKV = 53 * MiB;
constexpr size_t WS_CQKV = 197 * MiB;
constexpr size_t WS_KR = 245 * MiB;
constexpr size_t WS_XN = 248 * MiB;
constexpr size_t WS_KVM = 344 * MiB;
constexpr size_t WS_QM = 440 * MiB;
constexpr size_t WS_WOUT = 440 * MiB;
constexpr size_t WS_ACT = 149 * MiB;
constexpr size_t WS_WGU = 413 * MiB;
constexpr size_t WS_WD = 457 * MiB;
constexpr size_t WS_END = 512 * MiB;
constexpr int NINP = 4352;

__device__ __forceinline__ unsigned cvt_pk_bf16(float lo, float hi) { unsigned r; asm volatile("v_cvt_pk_bf16_f32 %0, %1, %2" : "=v"(r) : "v"(lo), "v"(hi)); return r; }
__device__ __forceinline__ float bf_lo(unsigned u) { return __uint_as_float(u << 16); }
__device__ __forceinline__ float bf_hi(unsigned u) { return __uint_as_float(u & 0xffff0000u); }
template <int K> __device__ __forceinline__ float shx(float v) {
    return __int_as_float(__builtin_amdgcn_ds_swizzle(__float_as_int(v), (K << 10) | 0x1f));
}
__device__ __forceinline__ float add_halves(float v) { auto rr = __builtin_amdgcn_permlane32_swap(__float_as_uint(v), __float_as_uint(v), false, false); return __uint_as_float(rr[0]) + __uint_as_float(rr[1]); }
__device__ __forceinline__ float wave_sum(float v) {
    v += shx<1>(v); v += shx<2>(v); v += shx<4>(v); v += shx<8>(v); v += shx<16>(v);
    return add_halves(v);
}
__device__ __forceinline__ float sigmoidf_(float x) { return __builtin_amdgcn_rcpf(1.0f + __builtin_amdgcn_exp2f(-x * LOG2E)); }
__device__ __forceinline__ void atomic_addf(float* p, float v) { __hip_atomic_fetch_add(p, v, __ATOMIC_RELAXED, __HIP_MEMORY_SCOPE_AGENT); }

__device__ __forceinline__ int lane_id() { return (int)__builtin_amdgcn_mbcnt_hi(~0u, __builtin_amdgcn_mbcnt_lo(~0u, 0u)); }
#define XB_TMO      128
#define XB_XCNT(j)  (256  + 64 * (j))
#define XB_XSUB(j)  (1280 + 64 * (j))
#define XB_XGEN(j)  (2304 + 64 * (j))
#define XB_TOP      3328
#define XB_TOPGEN   3392
#define XCD_BAR_WORDS 3456
#define XB_SPIN_CAP (1u << 22)
__device__ __forceinline__ unsigned xb_ld(unsigned* p)              { return __hip_atomic_load(p, __ATOMIC_RELAXED, __HIP_MEMORY_SCOPE_AGENT); }
__device__ __forceinline__ unsigned xb_add(unsigned* p, unsigned v) { return __hip_atomic_fetch_add(p, v, __ATOMIC_RELAXED, __HIP_MEMORY_SCOPE_AGENT); }
__device__ __forceinline__ unsigned xb_xcc_id() { return (unsigned)__builtin_amdgcn_s_getreg((3 << 11) | 20) & 0xFu; }
#define XB_SPIN(cond, bar) do { unsigned _sp = 0; while (cond) { __builtin_amdgcn_s_sleep(1); \
    if ((++_sp & 255u) == 0u) { if (xb_ld(&(bar)[XB_TMO])) break; if (_sp > XB_SPIN_CAP) { atomicAdd(&(bar)[XB_TMO], 1u); break; } } } } while (0)
__device__ __forceinline__ void xcd_barrier_complete(unsigned* bar, unsigned x, unsigned G, unsigned& nloc, unsigned& nx) {
    unsigned sum, cnt, mine, sp = 0u;
    for (;;) {
        sum = 0u; cnt = 0u; mine = 0u;
#pragma unroll
        for (unsigned j = 0; j < 16; ++j) { const unsigned c = xb_ld(&bar[XB_XCNT(j)]); sum += c; cnt += (c > 0u) ? 1u : 0u; mine = (j == x) ? c : mine; }
        if (sum == G) break;
        __builtin_amdgcn_s_sleep(1);
        if ((++sp & 255u) == 0u) { if (xb_ld(&bar[XB_TMO])) break; if (sp > XB_SPIN_CAP) { atomicAdd(&bar[XB_TMO], 1u); break; } }
    }
    nloc = mine > 0u ? mine : 1u; nx = cnt > 0u ? cnt : 1u;
}
__device__ __forceinline__ void xcd_barrier(unsigned* bar, volatile LAS unsigned* st, bool leader) {
    asm volatile("s_waitcnt vmcnt(0)" ::: "memory");
    __syncthreads();
    if (leader) {
        __builtin_amdgcn_s_waitcnt(0);
        const unsigned x = xb_xcc_id();
        unsigned nloc = st[0], nx = st[1];
        if (nloc == 0u) { xcd_barrier_complete(bar, x, gridDim.x, nloc, nx); st[0] = nloc; st[1] = nx; }
        const unsigned old = xb_add(&bar[XB_XSUB(x)], 1u);
        const unsigned gen = old / nloc;
        if (old + 1u == (gen + 1u) * nloc) {
            __builtin_amdgcn_fence(__ATOMIC_RELEASE, "agent");
            asm volatile("s_waitcnt vmcnt(0)" ::: "memory");
            const unsigned og = xb_add(&bar[XB_TOP], 1u);
            const unsigned tg = og / nx;
            if (og + 1u == (tg + 1u) * nx) xb_add(&bar[XB_TOPGEN], 1u);
            else XB_SPIN(xb_ld(&bar[XB_TOPGEN]) == tg, bar);
            __builtin_amdgcn_fence(__ATOMIC_ACQUIRE, "agent");
            xb_add(&bar[XB_XGEN(x)], 1u);
            asm volatile("s_waitcnt vmcnt(0)" ::: "memory");
        } else {
            XB_SPIN(xb_ld(&bar[XB_XGEN(x)]) == gen, bar);
            __builtin_amdgcn_fence(__ATOMIC_ACQUIRE, "agent");
            asm volatile("s_waitcnt vmcnt(0)" ::: "memory");
        }
    }
    __syncthreads();
}

namespace pg8 {
constexpr int BM = 256, BK = 64, HALF = 128, HTB = HALF * BK * 2, STAGE_BYTES = 8 * HTB, NXCD = 8, WGM = 8;
__host__ __device__ __forceinline__ int lds_byte(int r, int c) { const int st = (r >> 4) * 2 + (c >> 5), rr = r & 15, cc = c & 31, ob = rr * 64 + cc * 2; return st * 1024 + (ob ^ (((ob >> 9) & 1) << 5)); }
__host__ __device__ __forceinline__ void stage_rc(int b, int& R, int& C) { const int st = b / 1024, sb = b % 1024, swz = sb ^ (((sb >> 9) & 1) << 5); R = (st >> 1) * 16 + swz / 64; C = (st & 1) * 32 + (swz % 64) / 2; }
__host__ __device__ __forceinline__ int perm32(int rho) { const int n = rho >> 4, i = rho & 15; return 8 * (i >> 2) + 4 * n + (i & 3); }

struct Unit { int pm, pn; };
struct Gemm { const bf16_t* A; const bf16_t* Bt; int M, N, K, lda; };
struct StaticOrder {
    int nM, nN, nwg, G, c;
    __device__ void init(int M, int N, int G_, int c_) { nM = M / BM; nN = N / BM; nwg = nM * nN; G = G_; c = c_; }
    __device__ bool next(int i, Unit& u) const {
        const long L = (long)i * G + c; if (L >= nwg) return false;
        int wgid = (int)L; { const int q = nwg / NXCD, r = nwg % NXCD, xcd = wgid % NXCD, off = wgid / NXCD; wgid = (xcd < r ? xcd * (q + 1) : r * (q + 1) + (xcd - r) * q) + off; }
        const int nig = WGM * nN, gid = wgid / nig, fm = gid * WGM, gsz = (nM - fm) < WGM ? (nM - fm) : WGM;
        u.pm = fm + ((wgid % nig) % gsz); u.pn = (wgid % nig) / gsz; return true;
    }
};

template <class Epi, class Sched>
__device__ __forceinline__ void gemm_phase(LAS unsigned char* lds, const Gemm g, const Sched& S, const Epi& E, int wv) {
    int tid = wv * 64 + lane_id(); asm volatile("" : "+v"(tid));
    const int wid = __builtin_amdgcn_readfirstlane(tid >> 6), lane = tid & 63, wr = wid >> 2, wc = wid & 3, fr = lane & 15, fq = lane >> 4;
    const int K = g.K, nt = K / BK, lda = g.lda;
    unsigned voffA[2], voffB[2];
#pragma unroll
    for (int i = 0; i < 2; ++i) { int R, C; stage_rc(tid * 16 + i * 8192, R, C); const int Rb = Epi::PERM ? ((R & ~31) + perm32(R & 31)) : R;
        voffA[i] = (unsigned)(R * lda + C) * 2u; voffB[i] = (unsigned)(Rb * K + C) * 2u; }
    const size_t kstep = (size_t)(BK * 2);
    const size_t hstepA = (size_t)HALF * lda * 2, hstepB = (size_t)HALF * K * 2;
    const size_t tstepA = 2 * hstepA, tstepB = 2 * hstepB;
    const unsigned ldsw = (unsigned)wid * 1024u;
    const int aoff = lds_byte(wr * 64 + fr, fq * 8), boff = lds_byte(wc * 32 + fr, fq * 8);
#define PG8_SA(b, h) (((b) * 2 + (h)) * HTB)
#define PG8_SB(b, h) ((4 + (b) * 2 + (h)) * HTB)
#define PG8_STAGE(bufoff, gbase, voff) do { _Pragma("unroll") for (int _i = 0; _i < 2; ++_i) \
        __builtin_amdgcn_global_load_lds((const unsigned*)((const char*)(gbase) + (voff)[_i]), (LAS unsigned*)(lds + (bufoff) + ldsw + _i * 8192), 16, 0, 0); } while (0)
#define PG8_LDA(dst, b, h) do { _Pragma("unroll") for (int m = 0; m < 4; ++m) _Pragma("unroll") for (int k = 0; k < 2; ++k) dst[m][k] = *(const LAS bf16x8*)(lds + PG8_SA(b, h) + aoff + m * 2048 + k * 1024); } while (0)
#define PG8_LDB(dst, b, h) do { _Pragma("unroll") for (int n = 0; n < 2; ++n) _Pragma("unroll") for (int k = 0; k < 2; ++k) dst[n][k] = *(const LAS bf16x8*)(lds + PG8_SB(b, h) + boff + n * 2048 + k * 1024); } while (0)
#define PG8_MMA(ai, bj, At, Bt) do { __builtin_amdgcn_s_setprio(1); _Pragma("unroll") for (int m = 0; m < 4; ++m) _Pragma("unroll") for (int n = 0; n < 2; ++n) _Pragma("unroll") for (int k = 0; k < 2; ++k) \
        acc[ai][bj][m][n] = __builtin_amdgcn_mfma_f32_16x16x32_bf16(Bt[n][k], At[m][k], acc[ai][bj][m][n], 0, 0, 0); __builtin_amdgcn_s_setprio(0); } while (0)
#define PG8_WAIT_V(n) asm volatile("s_waitcnt vmcnt(" #n ")" ::: "memory")
#define PG8_WAIT_L(n) asm volatile("s_waitcnt lgkmcnt(" #n ")" ::: "memory")
#define PG8_BAR __builtin_amdgcn_s_barrier()
#define PG8_SCHED __builtin_amdgcn_sched_barrier(0)
    Unit cur, nxt; int ui = 0;
    if (!S.next(0, cur)) return;
    f32x4 acc[2][2][4][2];
#pragma unroll
    for (int a = 0; a < 2; ++a)
#pragma unroll
        for (int b = 0; b < 2; ++b)
#pragma unroll
            for (int m = 0; m < 4; ++m)
#pragma unroll
                for (int n = 0; n < 2; ++n) acc[a][b][m][n] = (f32x4){0.f, 0.f, 0.f, 0.f};
    bf16x8 At[4][2], B0[2][2], B1[2][2];
    const char* cA = (const char*)g.A + (size_t)cur.pm * tstepA; const char* cB = (const char*)g.Bt + (size_t)cur.pn * tstepB;
    PG8_STAGE(PG8_SB(0, 0), cB, voffB); PG8_STAGE(PG8_SB(0, 1), cB + hstepB, voffB); PG8_STAGE(PG8_SA(0, 0), cA, voffA); PG8_STAGE(PG8_SA(0, 1), cA + hstepA, voffA);
    if (wr == 1) PG8_BAR;
    PG8_WAIT_V(2); PG8_BAR;
    PG8_STAGE(PG8_SB(1, 0), cB + kstep, voffB); PG8_STAGE(PG8_SA(1, 0), cA + kstep, voffA); PG8_STAGE(PG8_SB(1, 1), cB + hstepB + kstep, voffB);
    PG8_WAIT_V(6); PG8_BAR;
    for (;;) {
        const bool has_next = S.next(ui + 1, nxt);
        const char* nA = has_next ? (const char*)g.A + (size_t)nxt.pm * tstepA : cA; const char* nB = has_next ? (const char*)g.Bt + (size_t)nxt.pn * tstepB : cB;
        for (int t = 0; t < nt; t += 2) {
            const bool last = (t == nt - 2);
            const char* a1 = cA + (size_t)(t + 1) * kstep;
            const char* a2 = last ? nA : cA + (size_t)(t + 2) * kstep; const char* b2 = last ? nB : cB + (size_t)(t + 2) * kstep;
            const char* a3 = a2 + kstep; const char* b3 = b2 + kstep;
            PG8_LDB(B0, 0, 0); PG8_LDB(B1, 0, 1); PG8_SCHED; PG8_LDA(At, 0, 0); PG8_STAGE(PG8_SA(1, 1), a1 + hstepA, voffA);
            PG8_WAIT_V(8); PG8_WAIT_L(0); PG8_BAR; PG8_MMA(0, 0, At, B0); PG8_MMA(0, 1, At, B1); PG8_BAR; PG8_SCHED;
            PG8_LDA(At, 0, 1); PG8_STAGE(PG8_SB(0, 0), b2, voffB); PG8_STAGE(PG8_SB(0, 1), b2 + hstepB, voffB); PG8_STAGE(PG8_SA(0, 0), a2, voffA);
            PG8_WAIT_V(8); PG8_WAIT_L(0); PG8_BAR; PG8_MMA(1, 0, At, B0); PG8_MMA(1, 1, At, B1); PG8_BAR; PG8_SCHED;
            PG8_LDB(B0, 1, 0); PG8_LDB(B1, 1, 1); PG8_SCHED; PG8_LDA(At, 1, 0); PG8_STAGE(PG8_SA(0, 1), a2 + hstepA, voffA);
            PG8_WAIT_V(8); PG8_WAIT_L(0); PG8_BAR; PG8_MMA(0, 0, At, B0); PG8_MMA(0, 1, At, B1); PG8_BAR; PG8_SCHED;
            PG8_LDA(At, 1, 1); PG8_STAGE(PG8_SB(1, 0), b3, voffB); PG8_STAGE(PG8_SB(1, 1), b3 + hstepB, voffB); PG8_STAGE(PG8_SA(1, 0), a3, voffA);
            PG8_WAIT_V(8); PG8_WAIT_L(0); PG8_BAR; PG8_MMA(1, 0, At, B0); PG8_MMA(1, 1, At, B1); PG8_BAR; PG8_SCHED;
        }
        if (wr == 0) PG8_BAR;
        E(acc, cur, wr, wc, fr, fq);
        if (!has_next) break;
#pragma unroll
        for (int a = 0; a < 2; ++a)
#pragma unroll
            for (int b = 0; b < 2; ++b)
#pragma unroll
                for (int m = 0; m < 4; ++m)
#pragma unroll
                    for (int n = 0; n < 2; ++n) acc[a][b][m][n] = (f32x4){0.f, 0.f, 0.f, 0.f};
        cur = nxt; cA = nA; cB = nB; ++ui;
        if (wr == 1) PG8_BAR;
    }
    PG8_WAIT_V(0);
    PG8_BAR;
#undef PG8_SA
#undef PG8_SB
#undef PG8_STAGE
#undef PG8_LDA
#undef PG8_LDB
#undef PG8_MMA
#undef PG8_WAIT_V
#undef PG8_WAIT_L
#undef PG8_BAR
#undef PG8_SCHED
}
}

typedef const f32x4 (&AccRef)[2][2][4][2];
__device__ __forceinline__ u32x4 pack8(f32x4 v0, f32x4 v1) { u32x4 w; w.x = cvt_pk_bf16(v0[0], v0[1]); w.y = cvt_pk_bf16(v0[2], v0[3]); w.z = cvt_pk_bf16(v1[0], v1[1]); w.w = cvt_pk_bf16(v1[2], v1[3]); return w; }
__device__ __forceinline__ float sumsq4(f32x4 v) { return (v[0] * v[0] + v[1] * v[1]) + (v[2] * v[2] + v[3] * v[3]); }

struct EpiIn {
    static constexpr bool PERM = true;
    bf16_t* QKV; bf16_t* CQKV; bf16_t* KR; float* ssq_q; float* ssq_kv; const float* tda; const float* tmla;
    __device__ __forceinline__ void operator()(AccRef acc, const pg8::Unit& u, int wr, int wc, int fr, int fq) const {
        const int pn = u.pn, row0 = u.pm * 256 + wr * 64 + fr, cl = wc * 32 + 8 * fq;
        if (pn < 12) {
            const bool rope = (pn < 8) && ((wc & 1) == 0) && (fq < 2);
#pragma unroll
            for (int ai = 0; ai < 2; ++ai)
#pragma unroll
                for (int m = 0; m < 4; ++m) {
                    const int row = row0 + ai * 128 + m * 16; const int pos = row < S0 ? row : row - S0;
                    f32x4 cs = (f32x4){1.f, 1.f, 1.f, 1.f}, sn = (f32x4){0.f, 0.f, 0.f, 0.f};
                    if (rope) { cs = *(const f32x4*)(tda + (size_t)pos * 16 + 4 * fq); sn = *(const f32x4*)(tda + (size_t)pos * 16 + 8 + 4 * fq); }
#pragma unroll
                    for (int bj = 0; bj < 2; ++bj) {
                        const f32x4 v0 = acc[ai][bj][m][0], v1 = acc[ai][bj][m][1];
                        const f32x4 o0 = v0 * cs - v1 * sn, o1 = v1 * cs + v0 * sn;
                        *(u32x4*)(QKV + (size_t)row * 3072 + pn * 256 + bj * 128 + cl) = rope ? pack8(o0, o1) : pack8(v0, v1);
                    }
                }
        } else if (pn < 16) {
            float* ssq = pn < 14 ? ssq_q : ssq_kv;
#pragma unroll
            for (int ai = 0; ai < 2; ++ai)
#pragma unroll
                for (int m = 0; m < 4; ++m) {
                    const int row = row0 + ai * 128 + m * 16; float s = 0.f;
#pragma unroll
                    for (int bj = 0; bj < 2; ++bj) {
                        const f32x4 v0 = acc[ai][bj][m][0], v1 = acc[ai][bj][m][1];
                        s += sumsq4(v0) + sumsq4(v1);
                        *(u32x4*)(CQKV + (size_t)row * 1024 + (pn - 12) * 256 + bj * 128 + cl) = pack8(v0, v1);
                    }
                    s += shx<16>(s); s = add_halves(s);
                    if (fq == 0) ssq[(size_t)row * 8 + (pn & 1) * 4 + wc] = s;
                }
        } else {
            if (wc < 2) {
                const int g4 = 4 * (4 * wc + fq);
#pragma unroll
                for (int ai = 0; ai < 2; ++ai)
#pragma unroll
                    for (int m = 0; m < 4; ++m) {
                        const int row = row0 + ai * 128 + m * 16; const int pos = row < S0 ? row : row - S0;
                        const f32x4 cs = *(const f32x4*)(tmla + (size_t)pos * 64 + g4), sn = *(const f32x4*)(tmla + (size_t)pos * 64 + 32 + g4);
                        const f32x4 v0 = acc[ai][0][m][0], v1 = acc[ai][0][m][1];
                        const f32x4 o0 = v0 * cs - v1 * sn, o1 = v1 * cs + v0 * sn;
                        *(u32x4*)(KR + (size_t)row * 64 + cl) = pack8(o0, o1);
                    }
            }
        }
    }
};
struct EpiQb {
    static constexpr bool PERM = true;
    bf16_t* QM; const float* ssq_q; const float* tmla;
    __device__ __forceinline__ void operator()(AccRef acc, const pg8::Unit& u, int wr, int wc, int fr, int fq) const {
        const int pn = u.pn, row0 = u.pm * 256 + wr * 64 + fr, cl = wc * 32 + 8 * fq;
        const int g4 = 4 * (4 * (wc & 1) + fq);
        const bool rp0 = ((pn * 4 + 0 + (wc >> 1)) % 3) == 2, rp1 = ((pn * 4 + 2 + (wc >> 1)) % 3) == 2;
#pragma unroll
        for (int ai = 0; ai < 2; ++ai)
#pragma unroll
            for (int m = 0; m < 4; ++m) {
                const int row = row0 + ai * 128 + m * 16; const int pos = row < S0 ? row : row - S0;
                const f32x4 sa = *(const f32x4*)(ssq_q + (size_t)row * 8), sb = *(const f32x4*)(ssq_q + (size_t)row * 8 + 4);
                const float rs = rsqrtf((((sa[0] + sa[1]) + (sa[2] + sa[3])) + ((sb[0] + sb[1]) + (sb[2] + sb[3]))) * (1.0f / 512.0f) + EPS);
                f32x4 cs = (f32x4){1.f, 1.f, 1.f, 1.f}, sn = (f32x4){0.f, 0.f, 0.f, 0.f};
                if (rp0 || rp1) { cs = *(const f32x4*)(tmla + (size_t)pos * 64 + g4); sn = *(const f32x4*)(tmla + (size_t)pos * 64 + 32 + g4); }
#pragma unroll
                for (int bj = 0; bj < 2; ++bj) {
                    const bool rp = bj ? rp1 : rp0;
                    const f32x4 v0 = acc[ai][bj][m][0] * rs, v1 = acc[ai][bj][m][1] * rs;
                    const f32x4 o0 = v0 * cs - v1 * sn, o1 = v1 * cs + v0 * sn;
                    *(u32x4*)(QM + (size_t)row * 1536 + pn * 256 + bj * 128 + cl) = rp ? pack8(o0, o1) : pack8(v0, v1);
                }
            }
    }
};
struct EpiScale {
    static constexpr bool PERM = true;
    bf16_t* O; int ldo; const float* ssq; float inv_n;
    __device__ __forceinline__ void operator()(AccRef acc, const pg8::Unit& u, int wr, int wc, int fr, int fq) const {
        const int pn = u.pn, row0 = u.pm * 256 + wr * 64 + fr, cl = wc * 32 + 8 * fq;
#pragma unroll
        for (int ai = 0; ai < 2; ++ai)
#pragma unroll
            for (int m = 0; m < 4; ++m) {
                const int row = row0 + ai * 128 + m * 16;
                const f32x4 sa = *(const f32x4*)(ssq + (size_t)row * 8), sb = *(const f32x4*)(ssq + (size_t)row * 8 + 4);
                const float rs = rsqrtf((((sa[0] + sa[1]) + (sa[2] + sa[3])) + ((sb[0] + sb[1]) + (sb[2] + sb[3]))) * inv_n + EPS);
#pragma unroll
                for (int bj = 0; bj < 2; ++bj)
                    *(u32x4*)(O + (size_t)row * ldo + pn * 256 + bj * 128 + cl) = pack8(acc[ai][bj][m][0] * rs, acc[ai][bj][m][1] * rs);
            }
    }
};
__device__ __forceinline__ void unpack8(u32x4 w, f32x4& a, f32x4& b) { a = (f32x4){bf_lo(w.x), bf_hi(w.x), bf_lo(w.y), bf_hi(w.y)}; b = (f32x4){bf_lo(w.z), bf_hi(w.z), bf_lo(w.w), bf_hi(w.w)}; }
struct EpiPlain {
    static constexpr bool PERM = true;
    bf16_t* O; int ldo;
    __device__ __forceinline__ void operator()(AccRef acc, const pg8::Unit& u, int wr, int wc, int fr, int fq) const {
        const int pn = u.pn, row0 = u.pm * 256 + wr * 64 + fr, cl = wc * 32 + 8 * fq;
#pragma unroll
        for (int ai = 0; ai < 2; ++ai)
#pragma unroll
            for (int m = 0; m < 4; ++m) {
                const int row = row0 + ai * 128 + m * 16;
#pragma unroll
                for (int bj = 0; bj < 2; ++bj) *(u32x4*)(O + (size_t)row * ldo + pn * 256 + bj * 128 + cl) = pack8(acc[ai][bj][m][0], acc[ai][bj][m][1]);
            }
    }
};
template <int MODE> struct EpiGate {
    static constexpr bool PERM = true;
    bf16_t* MRG; const bf16_t* TMP;
    __device__ __forceinline__ void operator()(AccRef acc, const pg8::Unit& u, int wr, int wc, int fr, int fq) const {
        const int pn = u.pn, row0 = u.pm * 256 + wr * 64 + fr, cl = wc * 32 + 8 * fq;
#pragma unroll
        for (int ai = 0; ai < 2; ++ai)
#pragma unroll
            for (int m = 0; m < 4; ++m) {
                const int row = row0 + ai * 128 + m * 16;
#pragma unroll
                for (int bj = 0; bj < 2; ++bj) {
                    const size_t off = (size_t)row * 2048 + pn * 256 + bj * 128 + cl;
                    f32x4 g0 = acc[ai][bj][m][0], g1 = acc[ai][bj][m][1];
#pragma unroll
                    for (int e = 0; e < 4; ++e) { g0[e] = sigmoidf_(g0[e]); g1[e] = sigmoidf_(g1[e]); }
                    f32x4 m0, m1; unpack8(*(const u32x4*)(MRG + off), m0, m1);
                    if (MODE == 0) { m0 = m0 * g0; m1 = m1 * g1; }
                    else { f32x4 t0, t1; unpack8(*(const u32x4*)(TMP + off), t0, t1); m0 = m0 + g0 * t0; m1 = m1 + g1 * t1; }
                    *(u32x4*)(MRG + off) = pack8(m0, m1);
                }
            }
    }
};
struct EpiX1 {
    static constexpr bool PERM = true;
    const float* x0; const float* x1; bf16_t* XB;
    __device__ __forceinline__ void operator()(AccRef acc, const pg8::Unit& u, int wr, int wc, int fr, int fq) const {
        const int pn = u.pn, row0 = u.pm * 256 + wr * 64 + fr, cl = wc * 32 + 8 * fq;
#pragma unroll
        for (int ai = 0; ai < 2; ++ai)
#pragma unroll
            for (int m = 0; m < 4; ++m) {
                const int row = row0 + ai * 128 + m * 16;
                const float* xr = row < S0 ? x0 + (size_t)row * DM : x1 + (size_t)(row - S0) * DM;
#pragma unroll
                for (int bj = 0; bj < 2; ++bj) {
                    const int col = pn * 256 + bj * 128 + cl;
                    const f32x4 a0 = *(const f32x4*)(xr + col) + acc[ai][bj][m][0], a1 = *(const f32x4*)(xr + col + 4) + acc[ai][bj][m][1];
                    *(u32x4*)(XB + (size_t)row * DM + col) = pack8(a0, a1);
                }
            }
    }
};
struct EpiX2 {
    static constexpr bool PERM = true;
    bf16_t* XB;
    __device__ __forceinline__ void operator()(AccRef acc, const pg8::Unit& u, int wr, int wc, int fr, int fq) const {
        const int pn = u.pn, row0 = u.pm * 256 + wr * 64 + fr, cl = wc * 32 + 8 * fq;
#pragma unroll
        for (int ai = 0; ai < 2; ++ai)
#pragma unroll
            for (int m = 0; m < 4; ++m) {
                const int row = row0 + ai * 128 + m * 16;
#pragma unroll
                for (int bj = 0; bj < 2; ++bj) {
                    const size_t off = (size_t)row * DM + pn * 256 + bj * 128 + cl;
                    f32x4 m0, m1; unpack8(*(const u32x4*)(XB + off), m0, m1);
                    *(u32x4*)(XB + off) = pack8(m0 + acc[ai][bj][m][0], m1 + acc[ai][bj][m][1]);
                }
            }
    }
};
struct EpiSwiGLU {
    static constexpr bool PERM = true;
    bf16_t* ACT; const float* rstd;
    __device__ __forceinline__ void operator()(AccRef acc, const pg8::Unit& u, int wr, int wc, int fr, int fq) const {
        const int pn = u.pn, row0 = u.pm * 256 + wr * 64 + fr, cl = wc * 32 + 8 * fq;
#pragma unroll
        for (int ai = 0; ai < 2; ++ai)
#pragma unroll
            for (int m = 0; m < 4; ++m) {
                const int row = row0 + ai * 128 + m * 16;
                const float rs = rstd[row];
                f32x4 a[2];
#pragma unroll
                for (int n = 0; n < 2; ++n) { const f32x4 gt = acc[ai][0][m][n] * rs, up = acc[ai][1][m][n] * rs;
#pragma unroll
                    for (int e = 0; e < 4; ++e) a[n][e] = gt[e] * sigmoidf_(gt[e]) * up[e]; }
                *(u32x4*)(ACT + (size_t)row * FF + pn * 128 + cl) = pack8(a[0], a[1]);
            }
    }
};

namespace att {
constexpr int KVBLK = 64, SHM_V = 16384, SHM_K = 16384, SHM_KR = 8192;
#define KSWZ(row, colB) ((row) * 256 + ((colB) ^ (((row) & 15) << 4)))
#define KRSWZ(row, colB) ((row) * 128 + ((colB) ^ ((((row) >> 1) & 7) << 4)))
#define SBAR() __builtin_amdgcn_sched_barrier(0)
__device__ __forceinline__ int crow(int r, int hi) { return (r & 3) + 8 * (r >> 2) + 4 * hi; }
template <int MODE> struct Cst { static constexpr float SCALE = MODE ? 0.07216878364870322f : 0.125f; static constexpr float C = SCALE * LOG2E; static constexpr float THRS = 8.0f / SCALE; };

template <int MODE> __device__ __forceinline__ void partialSM(f32x16& p0, f32x16& p1, float& m_reg, float& mn, float& alpha) {
    constexpr float C = Cst<MODE>::C;
    float pmax = p0[0];
#pragma unroll
    for (int r = 1; r < 16; ++r) pmax = fmaxf(pmax, p0[r]);
#pragma unroll
    for (int r = 0; r < 16; ++r) pmax = fmaxf(pmax, p1[r]);
    { auto rr = __builtin_amdgcn_permlane32_swap(__float_as_uint(pmax), __float_as_uint(pmax), false, false);
      pmax = fmaxf(__uint_as_float(rr[0]), __uint_as_float(rr[1])); }
    if (__builtin_expect(__all(pmax - m_reg <= Cst<MODE>::THRS), 1)) { mn = m_reg; alpha = 1.f; }
    else { mn = fmaxf(m_reg, pmax); alpha = __builtin_amdgcn_exp2f((m_reg - mn) * C); m_reg = mn; }
    const float mnC = -mn * C;
#pragma unroll
    for (int r = 0; r < 16; ++r) p0[r] = fmaf(p0[r], C, mnC);
#pragma unroll
    for (int r = 0; r < 16; ++r) p1[r] = fmaf(p1[r], C, mnC);
#pragma unroll
    for (int r = 0; r < 16; ++r) p0[r] = __builtin_amdgcn_exp2f(p0[r]);
}
__device__ __forceinline__ void finishSM(f32x16& p0, f32x16& p1, float alpha, float& l_reg, bf16x8& pa0, bf16x8& pa1, bf16x8& pa2, bf16x8& pa3) {
#pragma unroll
    for (int r = 0; r < 16; ++r) p1[r] = __builtin_amdgcn_exp2f(p1[r]);
    float ps = 0;
#pragma unroll
    for (int r = 0; r < 16; ++r) ps += p0[r];
#pragma unroll
    for (int r = 0; r < 16; ++r) ps += p1[r];
    { auto rr = __builtin_amdgcn_permlane32_swap(__float_as_uint(ps), __float_as_uint(ps), false, false);
      ps = __uint_as_float(rr[0]) + __uint_as_float(rr[1]); }
    l_reg = l_reg * alpha + ps;
#define PK4(P, BASE, OUT) do { unsigned a0 = cvt_pk_bf16(P[BASE + 0], P[BASE + 1]), a1 = cvt_pk_bf16(P[BASE + 2], P[BASE + 3]);   \
    unsigned b0 = cvt_pk_bf16(P[BASE + 4], P[BASE + 5]), b1 = cvt_pk_bf16(P[BASE + 6], P[BASE + 7]);                              \
    auto r0 = __builtin_amdgcn_permlane32_swap(a0, b0, false, false); auto r1 = __builtin_amdgcn_permlane32_swap(a1, b1, false, false); \
    u32x4 w = {r0[0], r1[0], r0[1], r1[1]}; OUT = *reinterpret_cast<bf16x8*>(&w); } while (0)
    PK4(p0, 0, pa0); PK4(p0, 8, pa1); PK4(p1, 0, pa2); PK4(p1, 8, pa3);
#undef PK4
}
template <int MODE> __device__ __forceinline__ void qkt(f32x16& p0, f32x16& p1, const LAS unsigned char* Kt, const LAS unsigned char* Krt, const bf16x8* qr, int r32, int hi, int comp) {
    p0 = f32x16{}; p1 = f32x16{};
    constexpr int NDN = MODE ? 8 : 4;
#pragma unroll
    for (int d0 = 0; d0 < NDN; ++d0) { const int cb = ((MODE ? 0 : comp * 64) + d0 * 16 + hi * 8) * 2;
        const bf16x8 b0 = *(const LAS bf16x8*)(Kt + KSWZ(r32, cb));
        const bf16x8 b1 = *(const LAS bf16x8*)(Kt + KSWZ(32 + r32, cb));
        p0 = __builtin_amdgcn_mfma_f32_32x32x16_bf16(b0, qr[d0], p0, 0, 0, 0);
        p1 = __builtin_amdgcn_mfma_f32_32x32x16_bf16(b1, qr[d0], p1, 0, 0, 0); }
    if constexpr (MODE == 1) {
#pragma unroll
        for (int d0 = 0; d0 < 4; ++d0) { const int cb = (d0 * 16 + hi * 8) * 2;
            const bf16x8 b0 = *(const LAS bf16x8*)(Krt + KRSWZ(r32, cb));
            const bf16x8 b1 = *(const LAS bf16x8*)(Krt + KRSWZ(32 + r32, cb));
            p0 = __builtin_amdgcn_mfma_f32_32x32x16_bf16(b0, qr[8 + d0], p0, 0, 0, 0);
            p1 = __builtin_amdgcn_mfma_f32_32x32x16_bf16(b1, qr[8 + d0], p1, 0, 0, 0); }
    }
}
__device__ __forceinline__ int v_st(int k, int c) { const int kk = (k & ~0xC) | ((k & 4) << 1) | ((k & 8) >> 1); return ((kk >> 3) * 4 + (c >> 5)) * 512 + ((kk & 7) * 32 + (c & 31)) * 2; }
__device__ __forceinline__ int v_rd_base(int lane) { return ((lane & 3) << 3) | (((lane >> 2) & 3) << 6) | (((lane >> 4) & 1) << 5) | (((lane >> 5) & 1) << 8); }
constexpr int v_rd_off(int d0, int ks, int half) { return d0 * 512 + ks * 4096 + half * 2048; }
template <int OFF> __device__ __forceinline__ s16x4 tr_read(int vb) {
    s16x4 r; asm volatile("ds_read_b64_tr_b16 %0, %1 offset:%2" : "=&v"(r) : "v"(vb), "i"(OFF) : "memory"); return r;
}
template <int D0> __device__ __forceinline__ void pv_one(f32x16& od, int vb, bf16x8 pa0, bf16x8 pa1, bf16x8 pa2, bf16x8 pa3) {
    const s16x4 l0 = tr_read<v_rd_off(D0, 0, 0)>(vb), h0 = tr_read<v_rd_off(D0, 0, 1)>(vb), l1 = tr_read<v_rd_off(D0, 1, 0)>(vb), h1 = tr_read<v_rd_off(D0, 1, 1)>(vb);
    const s16x4 l2 = tr_read<v_rd_off(D0, 2, 0)>(vb), h2 = tr_read<v_rd_off(D0, 2, 1)>(vb), l3 = tr_read<v_rd_off(D0, 3, 0)>(vb), h3 = tr_read<v_rd_off(D0, 3, 1)>(vb);
    asm volatile("s_waitcnt lgkmcnt(0)" ::: "memory"); SBAR();
#define PK(L, H) (bf16x8){L[0], L[1], L[2], L[3], H[0], H[1], H[2], H[3]}
    od = __builtin_amdgcn_mfma_f32_32x32x16_bf16(pa0, PK(l0, h0), od, 0, 0, 0);
    od = __builtin_amdgcn_mfma_f32_32x32x16_bf16(pa1, PK(l1, h1), od, 0, 0, 0);
    od = __builtin_amdgcn_mfma_f32_32x32x16_bf16(pa2, PK(l2, h2), od, 0, 0, 0);
    od = __builtin_amdgcn_mfma_f32_32x32x16_bf16(pa3, PK(l3, h3), od, 0, 0, 0);
#undef PK
}
__device__ __forceinline__ void pv_d0(f32x16* o, int vb, bf16x8 pa0, bf16x8 pa1, bf16x8 pa2, bf16x8 pa3) {
    pv_one<0>(o[0], vb, pa0, pa1, pa2, pa3); pv_one<1>(o[1], vb, pa0, pa1, pa2, pa3); pv_one<2>(o[2], vb, pa0, pa1, pa2, pa3); pv_one<3>(o[3], vb, pa0, pa1, pa2, pa3);
}
__device__ __forceinline__ bf16_t f2bf(float f) { return (bf16_t)(cvt_pk_bf16(f, f) & 0xffffu); }

template <int MODE>
__device__ __forceinline__ void attn_unit(LAS unsigned char* lds, const bf16_t* Qb, const bf16_t* __restrict__ Kh, const bf16_t* __restrict__ Krh, const bf16_t* __restrict__ Vh,
                                          int seq, bf16_t* Ob, float lam, const float* __restrict__ subg, int wv) {
    constexpr int ND = MODE ? 12 : 4, LDQ = MODE ? 1536 : 3072, LDK = MODE ? 2048 : 3072, LDO = MODE ? 1024 : 3072, SD = MODE ? 1 : 2;
    constexpr int OFF_V = 0, OFF_K = 2 * SHM_V, OFF_KR = OFF_K + 2 * SHM_K, OFF_WS = MODE ? OFF_KR + 2 * SHM_KR : OFF_KR;
    int tid = wv * 64 + lane_id(); asm volatile("" : "+v"(tid));
    const int wid = __builtin_amdgcn_readfirstlane(tid >> 6), lane = tid & 63, r32 = lane & 31, hi = lane >> 5;
    const int comp = MODE ? 0 : (wid >> 2), wq = MODE ? wid : (wid & 3);
    LAS float* wsf = (LAS float*)(lds + OFF_WS) + wid * 64; LAS float* li_l = wsf; LAS float* al_l = wsf + 32;
    float m_reg = -1e30f, l_reg = 0; f32x16 o[4] = {}; bf16x8 qr[ND];
    const bf16_t* Qw = Qb + (size_t)(wq * 32 + r32) * LDQ + comp * 64 + hi * 8;
#pragma unroll
    for (int d0 = 0; d0 < ND; ++d0) qr[d0] = *(const bf16x8*)(Qw + d0 * 16);
    const int sr = tid >> 4, sc = (tid & 15) * 8, vst0 = v_st(sr, sc), vst1 = v_st(32 + sr, sc);
    const int krr = tid >> 3, krc = (tid & 7) * 8;
    const int vb0 = (int)(unsigned)(uintptr_t)(lds + OFF_V) + v_rd_base(lane);
    struct Slot { bf16x8 vs0, vs1, ks0, ks1, kr; } sl[SD];
#define SLOAD(i, k0) do { sl[i].vs0 = *(const bf16x8*)(Vh + (size_t)((k0) + sr) * LDK + sc); sl[i].vs1 = *(const bf16x8*)(Vh + (size_t)((k0) + 32 + sr) * LDK + sc); \
    sl[i].ks0 = *(const bf16x8*)(Kh + (size_t)((k0) + sr) * LDK + sc); sl[i].ks1 = *(const bf16x8*)(Kh + (size_t)((k0) + 32 + sr) * LDK + sc); \
    if constexpr (MODE == 1) sl[i].kr = *(const bf16x8*)(Krh + (size_t)((k0) + krr) * 64 + krc); } while (0)
#define SWRITE(b, i) do { *(LAS bf16x8*)(lds + OFF_V + (b) * SHM_V + vst0) = sl[i].vs0; *(LAS bf16x8*)(lds + OFF_V + (b) * SHM_V + vst1) = sl[i].vs1; \
    *(LAS bf16x8*)(lds + OFF_K + (b) * SHM_K + KSWZ(sr, sc * 2)) = sl[i].ks0; *(LAS bf16x8*)(lds + OFF_K + (b) * SHM_K + KSWZ(32 + sr, sc * 2)) = sl[i].ks1; \
    if constexpr (MODE == 1) *(LAS bf16x8*)(lds + OFF_KR + (b) * SHM_KR + KRSWZ(krr, krc * 2)) = sl[i].kr; } while (0)
#define SWAIT() do { if constexpr (SD == 2) asm volatile("s_waitcnt vmcnt(4)" ::: "memory"); else asm volatile("s_waitcnt vmcnt(0)" ::: "memory"); } while (0)
#define RESC(a) do { if (__any((a) < 1.f)) { if (hi == 0) al_l[r32] = (a); asm volatile("s_waitcnt lgkmcnt(0)" ::: "memory"); \
    _Pragma("unroll") for (int d = 0; d < 4; ++d) _Pragma("unroll") for (int r = 0; r < 16; ++r) o[d][r] *= al_l[crow(r, hi)]; } } while (0)
#define KB(b) (lds + OFF_K + (b) * SHM_K)
#define KRB(b) (lds + OFF_KR + (b) * SHM_KR)
    f32x16 pA0, pA1, pB0, pB1; float mnA, mnB, alA, alB; bf16x8 pa0, pa1, pa2, pa3; const int NT = seq / KVBLK;
    constexpr int SE = 0, SO = SD - 1;
    SLOAD(SE, 0); asm volatile("s_waitcnt vmcnt(0)" ::: "memory"); SWRITE(0, SE); __syncthreads();
    qkt<MODE>(pA0, pA1, KB(0), KRB(0), qr, r32, hi, comp); partialSM<MODE>(pA0, pA1, m_reg, mnA, alA);
    SLOAD(SO, KVBLK); if constexpr (SD == 2) { if (2 < NT) SLOAD(SE, 2 * KVBLK); }
    SWAIT(); SWRITE(1, SO); __syncthreads();
    for (int j = 1; j + 1 < NT; j += 2) {
        SBAR(); qkt<MODE>(pB0, pB1, KB(1), KRB(1), qr, r32, hi, comp);
        finishSM(pA0, pA1, alA, l_reg, pa0, pa1, pa2, pa3); SBAR();
        SLOAD(SO, (j + SD) * KVBLK); SBAR();
        pv_d0(o, vb0, pa0, pa1, pa2, pa3); partialSM<MODE>(pB0, pB1, m_reg, mnB, alB);
        __syncthreads(); SWAIT(); SWRITE(0, SE);
        RESC(alB); __syncthreads();
        SBAR(); qkt<MODE>(pA0, pA1, KB(0), KRB(0), qr, r32, hi, comp);
        finishSM(pB0, pB1, alB, l_reg, pa0, pa1, pa2, pa3); SBAR();
        if (SD == 1 || j + 3 < NT) SLOAD(SE, (j + 1 + SD) * KVBLK); SBAR();
        pv_d0(o, vb0 + SHM_V, pa0, pa1, pa2, pa3); partialSM<MODE>(pA0, pA1, m_reg, mnA, alA);
        __syncthreads(); SWAIT(); SWRITE(1, SO);
        RESC(alA); __syncthreads();
    }
    SBAR(); qkt<MODE>(pB0, pB1, KB(1), KRB(1), qr, r32, hi, comp);
    finishSM(pA0, pA1, alA, l_reg, pa0, pa1, pa2, pa3); SBAR();
    pv_d0(o, vb0, pa0, pa1, pa2, pa3); partialSM<MODE>(pB0, pB1, m_reg, mnB, alB);
    __syncthreads(); RESC(alB);
    finishSM(pB0, pB1, alB, l_reg, pa0, pa1, pa2, pa3); SBAR();
    pv_d0(o, vb0 + SHM_V, pa0, pa1, pa2, pa3);
    if (hi == 0) li_l[r32] = l_reg; asm volatile("s_waitcnt lgkmcnt(0)" ::: "memory");
    float rli[16];
#pragma unroll
    for (int r = 0; r < 16; ++r) rli[r] = __builtin_amdgcn_rcpf(li_l[crow(r, hi)]);
    if constexpr (MODE == 1) {
        bf16_t* Ow = Ob + (size_t)(wq * 32) * LDO;
#pragma unroll
        for (int r = 0; r < 16; ++r) { const int orow = crow(r, hi);
#pragma unroll
            for (int d0 = 0; d0 < 4; ++d0) Ow[(size_t)orow * LDO + d0 * 32 + r32] = f2bf(o[d0][r] * rli[r]); }
        __syncthreads();
    } else {
        __syncthreads();
        LAS float* X = (LAS float*)lds + (size_t)wq * 4096 + lane;
        if (comp == 1) {
#pragma unroll
            for (int d0 = 0; d0 < 4; ++d0)
#pragma unroll
                for (int r = 0; r < 16; ++r) X[(d0 * 16 + r) * 64] = o[d0][r] * rli[r];
        }
        __syncthreads();
        if (comp == 0) {
            float ss[16];
#pragma unroll
            for (int r = 0; r < 16; ++r) { float s = 0.f;
#pragma unroll
                for (int d0 = 0; d0 < 4; ++d0) { const float v = o[d0][r] * rli[r] - lam * X[(d0 * 16 + r) * 64]; o[d0][r] = v; s += v * v; }
                ss[r] = s; }
#pragma unroll
            for (int r = 0; r < 16; ++r) { float s = ss[r];
                s += shx<1>(s); s += shx<2>(s); s += shx<4>(s); s += shx<8>(s); s += shx<16>(s);
                ss[r] = rsqrtf(s * (1.0f / 128.0f) + EPS) * 0.8f; }
            float gg[4];
#pragma unroll
            for (int d0 = 0; d0 < 4; ++d0) gg[d0] = subg[d0 * 32 + r32];
            bf16_t* Ow = Ob + (size_t)(wq * 32) * LDO;
#pragma unroll
            for (int r = 0; r < 16; ++r) { const int orow = crow(r, hi);
#pragma unroll
                for (int d0 = 0; d0 < 4; ++d0) Ow[(size_t)orow * LDO + d0 * 32 + r32] = f2bf(o[d0][r] * ss[r] * gg[d0]); }
        }
        __syncthreads();
    }
#undef SLOAD
#undef SWRITE
#undef SWAIT
#undef RESC
#undef KB
#undef KRB
}
}

struct ColSrc { const float* p; int ld; };
template <class Map>
__device__ __forceinline__ void transpose_items(const Map mp, int K, int Nout, bf16_t* WT, const float* gain, LAS float* scr, int gw, int ngw, int lane) {
    const int nblk = Nout / 32, nitems = (K / 64) * nblk;
    for (int it = gw; it < nitems; it += ngw) {
        const int kb = it / nblk, nb = it % nblk, k0 = 64 * kb, n0 = 32 * nb;
        const ColSrc cs = mp(n0 + (lane & 31));
#pragma unroll 8
        for (int i = 0; i < 32; ++i) { const int kk = 2 * i + (lane >> 5);
            float v = cs.p ? cs.p[(size_t)(k0 + kk) * cs.ld] : 0.f; if (gain) v *= gain[k0 + kk];
            scr[kk * 33 + (lane & 31)] = v; }
        asm volatile("s_waitcnt lgkmcnt(0)" ::: "memory");
        const int c = lane & 7;
#pragma unroll
        for (int j = 0; j < 4; ++j) { const int n = (lane >> 3) + 8 * j; const LAS float* s = scr + (8 * c) * 33 + n;
            u32x4 o; o.x = cvt_pk_bf16(s[0 * 33], s[1 * 33]); o.y = cvt_pk_bf16(s[2 * 33], s[3 * 33]); o.z = cvt_pk_bf16(s[4 * 33], s[5 * 33]); o.w = cvt_pk_bf16(s[6 * 33], s[7 * 33]);
            *(u32x4*)(WT + (size_t)(n0 + n) * K + k0 + 8 * c) = o; }
        asm volatile("s_waitcnt lgkmcnt(0)" ::: "memory");
    }
}
__device__ __forceinline__ int rope_src(int j, int ng) { const int g = j >> 3; if (g >= ng) return j; return ((j & 7) < 4 ? 0 : 4 * ng) + 4 * g + (j & 3); }
struct MapIn { const float* w;
    __device__ ColSrc operator()(int n) const {
        int src;
        if (n < 2048) src = (n & ~63) + rope_src(n & 63, 2);
        else if (n < 4096) src = n;
        else if (n < 4160) src = 4096 + rope_src(n - 4096, 8);
        else return ColSrc{nullptr, 0};
        return ColSrc{w + src, 8256}; } };
struct MapG { const float* w;
    __device__ ColSrc operator()(int n) const { return ColSrc{w + 4160 + n, 8256}; } };
struct MapQb { const float* w;
    __device__ ColSrc operator()(int n) const { const int blk = n >> 6; const int src = (blk % 3 == 2) ? (n & ~63) + rope_src(n & 63, 8) : n; return ColSrc{w + src, 1536}; } };
struct MapId { const float* w; int ld;
    __device__ ColSrc operator()(int n) const { return ColSrc{w + n, ld}; } };
struct MapGu { const float* wg; const float* wu;
    __device__ ColSrc operator()(int n) const { const int t = n >> 8, r = n & 255; return r < 128 ? ColSrc{wg + t * 128 + r, FF} : ColSrc{wu + t * 128 + (r - 128), FF}; } };

struct Args {
    const float* in[21]; float* out; unsigned char* ws;
};
constexpr int NWAVES = 8;
constexpr int LDS_BYTES = 147456;

__global__ void __launch_bounds__(NWAVES * 64, 2) fwd_mega(Args a) {
    extern __shared__ __attribute__((aligned(16))) unsigned char lds_raw[];
    LAS unsigned char* lds = (LAS unsigned char*)lds_raw;
    cg::grid_group grid = cg::this_grid();
    const int G = gridDim.x, bx = blockIdx.x;
    const int wv = __builtin_amdgcn_readfirstlane((int)threadIdx.x >> 6);
    volatile LAS unsigned* bst = (volatile LAS unsigned*)(lds + 139264);
    if (threadIdx.x < 2) bst[threadIdx.x] = 0u;
    const int vcu = (G % 8 == 0) ? (bx % 8) * (G / 8) + bx / 8 : bx;
#define PHASE_PTRS() \
    size_t zoff_ = 0; asm volatile("" : "+s"(zoff_)); unsigned char* ws = a.ws + zoff_; \
    int tid = wv * 64 + lane_id(); asm volatile("" : "+v"(tid)); const int lane = tid & 63, wave = wv; (void)lane; (void)wave; \
    const int gw = vcu * NWAVES + wave, ngw = G * NWAVES; (void)gw; (void)ngw; \
    const float* x0 = a.in[0]; const float* x1 = a.in[1]; (void)x0; (void)x1; \
    float* ssq_q = (float*)(ws + WS_SSQ); float* ssq_kv = (float*)(ws + WS_SSQ + MiB); float* rstd1 = (float*)(ws + WS_RSTD); (void)ssq_q; (void)ssq_kv; (void)rstd1; \
    float* tda = (float*)(ws + WS_TDA); float* tmla = (float*)(ws + WS_TMLA); (void)tda; (void)tmla; \
    bf16_t* Wi = (bf16_t*)(ws + WS_WI); bf16_t* Wg = (bf16_t*)(ws + WS_WG); bf16_t* Wqb = (bf16_t*)(ws + WS_WQB); bf16_t* Wkvb = (bf16_t*)(ws + WS_WKVB); bf16_t* Wbda = (bf16_t*)(ws + WS_WBDA); \
    bf16_t* Wbmla = (bf16_t*)(ws + WS_WBMLA); bf16_t* Wout = (bf16_t*)(ws + WS_WOUT); bf16_t* Wgu = (bf16_t*)(ws + WS_WGU); bf16_t* Wd = (bf16_t*)(ws + WS_WD); \
    bf16_t* QKV = (bf16_t*)(ws + WS_QKV); bf16_t* TMP = QKV; bf16_t* X1B = QKV; bf16_t* CQKV = (bf16_t*)(ws + WS_CQKV); bf16_t* OM = CQKV; bf16_t* KR = (bf16_t*)(ws + WS_KR); \
    bf16_t* XN = (bf16_t*)(ws + WS_XN); bf16_t* KVM = (bf16_t*)(ws + WS_KVM); bf16_t* MRG = KVM; bf16_t* QM = (bf16_t*)(ws + WS_QM); bf16_t* ACT = (bf16_t*)(ws + WS_ACT); \
    (void)Wi; (void)Wg; (void)Wqb; (void)Wkvb; (void)Wbda; (void)Wbmla; (void)Wout; (void)Wgu; (void)Wd; (void)QKV; (void)TMP; (void)X1B; (void)CQKV; (void)OM; (void)KR; (void)XN; (void)KVM; (void)MRG; (void)QM; (void)ACT;
#define GRID_BAR() xcd_barrier((unsigned*)(a.ws + WS_BAR), bst, wv == 0 && lane_id() == 0)

    {
        PHASE_PTRS();
        LAS float* scr = (LAS float*)(lds + wave * 16384);
        if (bx == 0) for (int i = tid; i < XCD_BAR_WORDS; i += 512) ((unsigned*)(ws + WS_BAR))[i] = 0u;
        for (int i = bx * 512 + tid; i < S1 * 40; i += G * 512) {
            const int pos = i / 40, k = i % 40;
            const float expo = k < 8 ? (float)k * (1.0f / 8.0f) : (float)(k - 8) * (1.0f / 32.0f);
            const float inv = __builtin_amdgcn_exp2f(-expo * 18.931568569324174f);
            const float ang = (float)pos * inv;
            const double rev = (double)ang * 0.15915494309189535; const float fr = (float)(rev - __builtin_rint(rev));
            const float c = __builtin_amdgcn_cosf(fr), sn = __builtin_amdgcn_sinf(fr);
            if (k < 8) { tda[(size_t)pos * 16 + k] = c; tda[(size_t)pos * 16 + 8 + k] = sn; }
            else { tmla[(size_t)pos * 64 + (k - 8)] = c; tmla[(size_t)pos * 64 + 32 + (k - 8)] = sn; }
        }
        transpose_items(MapIn{a.in[3]}, 2048, NINP, Wi, nullptr, scr, gw, ngw, lane);
        transpose_items(MapG{a.in[3]}, 2048, 4096, Wg, nullptr, scr, gw, ngw, lane);
        transpose_items(MapQb{a.in[10]}, 512, 1536, Wqb, a.in[9], scr, gw, ngw, lane);
        transpose_items(MapId{a.in[12], 2048}, 512, 2048, Wkvb, a.in[11], scr, gw, ngw, lane);
        transpose_items(MapId{a.in[13], 2048}, 1024, 2048, Wbda, nullptr, scr, gw, ngw, lane);
        transpose_items(MapId{a.in[14], 2048}, 1024, 2048, Wbmla, nullptr, scr, gw, ngw, lane);
        const float* gn = a.in[2];
        for (int m = gw; m < T; m += ngw) {
            const float* xr = m < S0 ? x0 + (size_t)m * DM : x1 + (size_t)(m - S0) * DM;
            f32x4 v[8]; float sq = 0.f;
#pragma unroll
            for (int j = 0; j < 8; ++j) { v[j] = *(const f32x4*)(xr + j * 256 + lane * 4); sq += sumsq4(v[j]); }
            const float rs = rsqrtf(wave_sum(sq) * (1.0f / DM) + EPS);
#pragma unroll
            for (int j = 0; j < 8; ++j) { const f32x4 gv = *(const f32x4*)(gn + j * 256 + lane * 4); const f32x4 y = v[j] * rs * gv;
                u32x2 w; w.x = cvt_pk_bf16(y[0], y[1]); w.y = cvt_pk_bf16(y[2], y[3]); *(u32x2*)(XN + (size_t)m * DM + j * 256 + lane * 4) = w; }
        }
    }
    grid.sync();
    if (wv == 0 && lane_id() == 0) (void)xb_add(&((unsigned*)(a.ws + WS_BAR))[XB_XCNT(xb_xcc_id())], 1u);
    {
        PHASE_PTRS();
        pg8::Gemm g{XN, Wi, T, NINP, 2048, 2048}; pg8::StaticOrder S; S.init(T, NINP, G, bx);
        EpiIn E{QKV, CQKV, KR, ssq_q, ssq_kv, tda, tmla};
        pg8::gemm_phase(lds, g, S, E, wv);
    }
    GRID_BAR();
    {
        PHASE_PTRS();
        pg8::Gemm g{CQKV, Wqb, T, 1536, 512, 1024}; pg8::StaticOrder S; S.init(T, 1536, G, bx);
        EpiQb E{QM, ssq_q, tmla};
        pg8::gemm_phase(lds, g, S, E, wv);
    }
    {
        PHASE_PTRS();
        pg8::Gemm g{CQKV + 512, Wkvb, T, 2048, 512, 1024}; pg8::StaticOrder S; S.init(T, 2048, G, bx);
        EpiScale E{KVM, 2048, ssq_kv, 1.0f / 512.0f};
        pg8::gemm_phase(lds, g, S, E, wv);
    }
    GRID_BAR();
    {
        PHASE_PTRS();
        float lam;
        { const float a1 = a.in[4][lane] * a.in[5][lane], a2 = a.in[6][lane] * a.in[7][lane];
          lam = __builtin_amdgcn_exp2f(wave_sum(a1) * LOG2E) - __builtin_amdgcn_exp2f(wave_sum(a2) * LOG2E) + 0.2f; }
        const float* subg = a.in[8];
        for (int u = vcu; u < 1024 + 512; u += G) {
            const bool smp = u < 1024; const int uu = smp ? u : u - 1024;
            const int h = (uu & 255) >> 5, qb = (uu >> 8) * 32 + (uu & 31);
            const int seq0 = smp ? S0 : 0, seq = smp ? S1 : S0;
            const bf16_t* base = QKV + (size_t)seq0 * 3072 + h * 128;
            bf16_t* qp = QKV + (size_t)(seq0 + qb * 128) * 3072 + h * 128;
            att::attn_unit<0>(lds, qp, base + 1024, nullptr, base + 2048, seq, qp, lam, subg, wv);
        }
        for (int u = vcu; u < 512 + 256; u += G) {
            const bool smp = u < 512; const int uu = smp ? u : u - 512;
            const int h = (uu & 255) >> 5, qb = (uu >> 8) * 32 + (uu & 31);
            const int seq0 = smp ? S0 : 0, seq = smp ? S1 : S0;
            const bf16_t* qp = QM + (size_t)(seq0 + qb * 256) * 1536 + h * 192;
            const bf16_t* kp = KVM + (size_t)seq0 * 2048 + h * 256;
            att::attn_unit<1>(lds, qp, kp, KR + (size_t)seq0 * 64, kp + 128, seq, OM + (size_t)(seq0 + qb * 256) * 1024 + h * 128, 0.f, nullptr, wv);
        }
    }
    GRID_BAR();
    {
        PHASE_PTRS();
        LAS float* scr = (LAS float*)(lds + wave * 16384);
        transpose_items(MapId{a.in[15], 2048}, 2048, 2048, Wout, nullptr, scr, gw, ngw, lane);
        __syncthreads();
    }
    {
        PHASE_PTRS();
        pg8::Gemm g{QKV, Wbda, T, 2048, 1024, 3072}; pg8::StaticOrder S; S.init(T, 2048, G, bx);
        EpiPlain E{MRG, 2048};
        pg8::gemm_phase(lds, g, S, E, wv);
    }
    {
        PHASE_PTRS();
        pg8::Gemm g{XN, Wg, T, 2048, 2048, 2048}; pg8::StaticOrder S; S.init(T, 2048, G, bx);
        EpiGate<0> E{MRG, nullptr};
        pg8::gemm_phase(lds, g, S, E, wv);
    }
    GRID_BAR();
    {
        PHASE_PTRS();
        pg8::Gemm g{OM, Wbmla, T, 2048, 1024, 1024}; pg8::StaticOrder S; S.init(T, 2048, G, bx);
        EpiPlain E{TMP, 2048};
        pg8::gemm_phase(lds, g, S, E, wv);
    }
    {
        PHASE_PTRS();
        pg8::Gemm g{XN, Wg + (size_t)2048 * 2048, T, 2048, 2048, 2048}; pg8::StaticOrder S; S.init(T, 2048, G, bx);
        EpiGate<1> E{MRG, TMP};
        pg8::gemm_phase(lds, g, S, E, wv);
    }
    GRID_BAR();
    {
        PHASE_PTRS();
        pg8::Gemm g{MRG, Wout, T, 2048, 2048, 2048}; pg8::StaticOrder S; S.init(T, 2048, G, bx);
        EpiX1 E{x0, x1, X1B};
        pg8::gemm_phase(lds, g, S, E, wv);
    }
    GRID_BAR();
    {
        PHASE_PTRS();
        LAS float* scr = (LAS float*)(lds + wave * 16384);
        transpose_items(MapGu{a.in[17], a.in[18]}, 2048, 11264, Wgu, a.in[16], scr, gw, ngw, lane);
        transpose_items(MapId{a.in[19], 2048}, FF, 2048, Wd, nullptr, scr, gw, ngw, lane);
        for (int m = gw; m < T; m += ngw) {
            float sq = 0.f;
#pragma unroll
            for (int j = 0; j < 4; ++j) { f32x4 p, q; unpack8(*(const u32x4*)(X1B + (size_t)m * DM + j * 512 + lane * 8), p, q); sq += sumsq4(p) + sumsq4(q); }
            sq = wave_sum(sq);
            if (lane == 0) rstd1[m] = rsqrtf(sq * (1.0f / DM) + EPS);
        }
        __syncthreads();
    }
    GRID_BAR();
    {
        PHASE_PTRS();
        pg8::Gemm g{X1B, Wgu, T, 11264, 2048, 2048}; pg8::StaticOrder S; S.init(T, 11264, G, bx);
        EpiSwiGLU E{ACT, rstd1};
        pg8::gemm_phase(lds, g, S, E, wv);
    }
    GRID_BAR();
    {
        PHASE_PTRS();
        pg8::Gemm g{ACT, Wd, T, 2048, FF, FF}; pg8::StaticOrder S; S.init(T, 2048, G, bx);
        EpiX2 E{X1B};
        pg8::gemm_phase(lds, g, S, E, wv);
    }
    GRID_BAR();
    {
        PHASE_PTRS();
        const float* gn = a.in[20];
        for (int m = gw; m < T; m += ngw) {
            f32x4 v[8]; float sq = 0.f;
#pragma unroll
            for (int j = 0; j < 4; ++j) { unpack8(*(const u32x4*)(X1B + (size_t)m * DM + j * 512 + lane * 8), v[2 * j], v[2 * j + 1]); sq += sumsq4(v[2 * j]) + sumsq4(v[2 * j + 1]); }
            const float rs = rsqrtf(wave_sum(sq) * (1.0f / DM) + EPS);
            float* orow = a.out + (size_t)m * DM;
#pragma unroll
            for (int j = 0; j < 4; ++j) { const int c = j * 512 + lane * 8;
                *(f32x4*)(orow + c) = v[2 * j] * rs * *(const f32x4*)(gn + c); *(f32x4*)(orow + c + 4) = v[2 * j + 1] * rs * *(const f32x4*)(gn + c + 4); }
        }
    }
}

extern "C" void kernel_launch(void* const* d_in, const int* in_sizes, int n_in, void* d_out, int out_size, void* d_ws, size_t ws_size, hipStream_t stream) {
    static int grid = 0;
    if (grid == 0) {
        if (n_in != 21 || in_sizes[0] != S0 * DM || in_sizes[1] != S1 * DM || out_size != T * DM || ws_size < WS_END) {
            fprintf(stderr, "kernel_launch: shape mismatch n_in %d in0 %d in1 %d out %d ws %zu (need %zu)\n", n_in, n_in > 0 ? in_sizes[0] : -1, n_in > 1 ? in_sizes[1] : -1, out_size, ws_size, (size_t)WS_END);
            grid = -1; return; }
        int dev = 0, cus = 0, per_cu = 0;
        if (hipGetDevice(&dev) != hipSuccess || hipDeviceGetAttribute(&cus, hipDeviceAttributeMultiprocessorCount, dev) != hipSuccess) { grid = -1; return; }
        if (hipFuncSetAttribute((const void*)fwd_mega, hipFuncAttributeMaxDynamicSharedMemorySize, LDS_BYTES) != hipSuccess) { fprintf(stderr, "kernel_launch: hipFuncSetAttribute failed\n"); grid = -1; return; }
        if (hipOccupancyMaxActiveBlocksPerMultiprocessor(&per_cu, (const void*)fwd_mega, NWAVES * 64, LDS_BYTES) != hipSuccess || per_cu < 1) { fprintf(stderr, "kernel_launch: occupancy query says %d\n", per_cu); per_cu = 1; }
        (void)hipGetLastError();
        grid = cus * per_cu;
    }
    if (grid < 0) return;
    Args a{};
    for (int i = 0; i < 21; ++i) a.in[i] = (const float*)d_in[i];
    a.out = (float*)d_out; a.ws = (unsigned char*)d_ws;
    void* args[] = {&a};
    const hipError_t e = hipLaunchCooperativeKernel((void*)fwd_mega, dim3(grid), dim3(NWAVES * 64), args, LDS_BYTES, stream);
    if (e != hipSuccess) fprintf(stderr, "kernel_launch: cooperative launch failed: %s (grid %d)\n", hipGetErrorString(e), grid);
}
```

```cpp
#include <hip/hip_runtime.h>
#include <hip/hip_cooperative_groups.h>
#include <cstdio>
#include <cstdint>
namespace cg = cooperative_groups;

#define LAS __attribute__((address_space(3)))
typedef unsigned short bf16_t;
typedef short bf16x8 __attribute__((ext_vector_type(8)));
typedef short s16x4 __attribute__((ext_vector_type(4)));
typedef float f32x4 __attribute__((ext_vector_type(4)));
typedef float f32x16 __attribute__((ext_vector_type(16)));
typedef unsigned u32x4 __attribute__((ext_vector_type(4)));
typedef unsigned u32x2 __attribute__((ext_vector_type(2)));

constexpr int DM = 2048, S0 = 8192, S1 = 16384, T = S0 + S1;
constexpr int FF = 5632;
constexpr float EPS = 1e-6f;
constexpr float LOG2E = 1.4426950408889634f;

constexpr size_t MiB = 1u << 20;
constexpr size_t WS_SSQ = 0;
constexpr size_t WS_BAR = 2 * MiB;
constexpr size_t WS_RSTD = 2 * MiB + 256 * 1024;
constexpr size_t WS_TDA = 3 * MiB;
constexpr size_t WS_TMLA = 4 * MiB;
constexpr size_t WS_WI = 8 * MiB;
constexpr size_t WS_WG = 25 * MiB;
constexpr size_t WS_WQB = 41 * MiB;
constexpr size_t WS_WKVB = WS_WQB + 3 * MiB / 2;
constexpr size_t WS_WBDA = WS_WKVB + 2 * MiB;
constexpr size_t WS_WBMLA = WS_WBDA + 4 * MiB;
constexpr size_t WS_QKV = 53 * MiB;
constexpr size_t WS_CQKV = 197 * MiB;
constexpr size_t WS_KR = 245 * MiB;
constexpr size_t WS_XN = 248 * MiB;
constexpr size_t WS_KVM = 344 * MiB;
constexpr size_t WS_QM = 440 * MiB;
constexpr size_t WS_WOUT = 440 * MiB;
constexpr size_t WS_ACT = 149 * MiB;
constexpr size_t WS_WGU = 413 * MiB;
constexpr size_t WS_WD = 457 * MiB;
constexpr size_t WS_END = 512 * MiB;
constexpr int NINP = 4352;

__device__ __forceinline__ unsigned cvt_pk_bf16(float lo, float hi) { unsigned r; asm volatile("v_cvt_pk_bf16_f32 %0, %1, %2" : "=v"(r) : "v"(lo), "v"(hi)); return r; }
__device__ __forceinline__ float bf_lo(unsigned u) { return __uint_as_float(u << 16); }
__device__ __forceinline__ float bf_hi(unsigned u) { return __uint_as_float(u & 0xffff0000u); }
template <int K> __device__ __forceinline__ float shx(float v) {
    return __int_as_float(__builtin_amdgcn_ds_swizzle(__float_as_int(v), (K << 10) | 0x1f));
}
__device__ __forceinline__ float add_halves(float v) { auto rr = __builtin_amdgcn_permlane32_swap(__float_as_uint(v), __float_as_uint(v), false, false); return __uint_as_float(rr[0]) + __uint_as_float(rr[1]); }
__device__ __forceinline__ float wave_sum(float v) {
    v += shx<1>(v); v += shx<2>(v); v += shx<4>(v); v += shx<8>(v); v += shx<16>(v);
    return add_halves(v);
}
__device__ __forceinline__ float sigmoidf_(float x) { return __builtin_amdgcn_rcpf(1.0f + __builtin_amdgcn_exp2f(-x * LOG2E)); }
__device__ __forceinline__ void atomic_addf(float* p, float v) { __hip_atomic_fetch_add(p, v, __ATOMIC_RELAXED, __HIP_MEMORY_SCOPE_AGENT); }

__device__ __forceinline__ int lane_id() { return (int)__builtin_amdgcn_mbcnt_hi(~0u, __builtin_amdgcn_mbcnt_lo(~0u, 0u)); }
#define XB_TMO      128
#define XB_XCNT(j)  (256  + 64 * (j))
#define XB_XSUB(j)  (1280 + 64 * (j))
#define XB_XGEN(j)  (2304 + 64 * (j))
#define XB_TOP      3328
#define XB_TOPGEN   3392
#define XCD_BAR_WORDS 3456
#define XB_SPIN_CAP (1u << 22)
__device__ __forceinline__ unsigned xb_ld(unsigned* p)              { return __hip_atomic_load(p, __ATOMIC_RELAXED, __HIP_MEMORY_SCOPE_AGENT); }
__device__ __forceinline__ unsigned xb_add(unsigned* p, unsigned v) { return __hip_atomic_fetch_add(p, v, __ATOMIC_RELAXED, __HIP_MEMORY_SCOPE_AGENT); }
__device__ __forceinline__ unsigned xb_xcc_id() { return (unsigned)__builtin_amdgcn_s_getreg((3 << 11) | 20) & 0xFu; }
#define XB_SPIN(cond, bar) do { unsigned _sp = 0; while (cond) { __builtin_amdgcn_s_sleep(1); \
    if ((++_sp & 255u) == 0u) { if (xb_ld(&(bar)[XB_TMO])) break; if (_sp > XB_SPIN_CAP) { atomicAdd(&(bar)[XB_TMO], 1u); break; } } } } while (0)
__device__ __forceinline__ void xcd_barrier_complete(unsigned* bar, unsigned x, unsigned G, unsigned& nloc, unsigned& nx) {
    unsigned sum, cnt, mine, sp = 0u;
    for (;;) {
        sum = 0u; cnt = 0u; mine = 0u;
#pragma unroll
        for (unsigned j = 0; j < 16; ++j) { const unsigned c = xb_ld(&bar[XB_XCNT(j)]); sum += c; cnt += (c > 0u) ? 1u : 0u; mine = (j == x) ? c : mine; }
        if (sum == G) break;
        __builtin_amdgcn_s_sleep(1);
        if ((++sp & 255u) == 0u) { if (xb_ld(&bar[XB_TMO])) break; if (sp > XB_SPIN_CAP) { atomicAdd(&bar[XB_TMO], 1u); break; } }
    }
    nloc = mine > 0u ? mine : 1u; nx = cnt > 0u ? cnt : 1u;
}
__device__ __forceinline__ void xcd_barrier(unsigned* bar, volatile LAS unsigned* st, bool leader) {
    asm volatile("s_waitcnt vmcnt(0)" ::: "memory");
    __syncthreads();
    if (leader) {
        __builtin_amdgcn_s_waitcnt(0);
        const unsigned x = xb_xcc_id();
        unsigned nloc = st[0], nx = st[1];
        if (nloc == 0u) { xcd_barrier_complete(bar, x, gridDim.x, nloc, nx); st[0] = nloc; st[1] = nx; }
        const unsigned old = xb_add(&bar[XB_XSUB(x)], 1u);
        const unsigned gen = old / nloc;
        if (old + 1u == (gen + 1u) * nloc) {
            __builtin_amdgcn_fence(__ATOMIC_RELEASE, "agent");
            asm volatile("s_waitcnt vmcnt(0)" ::: "memory");
            const unsigned og = xb_add(&bar[XB_TOP], 1u);
            const unsigned tg = og / nx;
            if (og + 1u == (tg + 1u) * nx) xb_add(&bar[XB_TOPGEN], 1u);
            else XB_SPIN(xb_ld(&bar[XB_TOPGEN]) == tg, bar);
            __builtin_amdgcn_fence(__ATOMIC_ACQUIRE, "agent");
            xb_add(&bar[XB_XGEN(x)], 1u);
            asm volatile("s_waitcnt vmcnt(0)" ::: "memory");
        } else {
            XB_SPIN(xb_ld(&bar[XB_XGEN(x)]) == gen, bar);
            __builtin_amdgcn_fence(__ATOMIC_ACQUIRE, "agent");
            asm volatile("s_waitcnt vmcnt(0)" ::: "memory");
        }
    }
    __syncthreads();
}

namespace pg8 {
constexpr int BM = 256, BK = 64, HALF = 128, HTB = HALF * BK * 2, STAGE_BYTES = 8 * HTB, NXCD = 8, WGM = 8;
__host__ __device__ __forceinline__ int lds_byte(int r, int c) { const int st = (r >> 4) * 2 + (c >> 5), rr = r & 15, cc = c & 31, ob = rr * 64 + cc * 2; return st * 1024 + (ob ^ (((ob >> 9) & 1) << 5)); }
__host__ __device__ __forceinline__ void stage_rc(int b, int& R, int& C) { const int st = b / 1024, sb = b % 1024, swz = sb ^ (((sb >> 9) & 1) << 5); R = (st >> 1) * 16 + swz / 64; C = (st & 1) * 32 + (swz % 64) / 2; }
__host__ __device__ __forceinline__ int perm32(int rho) { const int n = rho >> 4, i = rho & 15; return 8 * (i >> 2) + 4 * n + (i & 3); }

struct Unit { int pm, pn; };
struct Gemm { const bf16_t* A; const bf16_t* Bt; int M, N, K, lda; };
struct StaticOrder {
    int nM, nN, nwg, G, c;
    __device__ void init(int M, int N, int G_, int c_) { nM = M / BM; nN = N / BM; nwg = nM * nN; G = G_; c = c_; }
    __device__ bool next(int i, Unit& u) const {
        const long L = (long)i * G + c; if (L >= nwg) return false;
        int wgid = (int)L; { const int q = nwg / NXCD, r = nwg % NXCD, xcd = wgid % NXCD, off = wgid / NXCD; wgid = (xcd < r ? xcd * (q + 1) : r * (q + 1) + (xcd - r) * q) + off; }
        const int nig = WGM * nN, gid = wgid / nig, fm = gid * WGM, gsz = (nM - fm) < WGM ? (nM - fm) : WGM;
        u.pm = fm + ((wgid % nig) % gsz); u.pn = (wgid % nig) / gsz; return true;
    }
};

template <class Epi, class Sched>
__device__ __forceinline__ void gemm_phase(LAS unsigned char* lds, const Gemm g, const Sched& S, const Epi& E, int wv) {
    int tid = wv * 64 + lane_id(); asm volatile("" : "+v"(tid));
    const int wid = __builtin_amdgcn_readfirstlane(tid >> 6), lane = tid & 63, wr = wid >> 2, wc = wid & 3, fr = lane & 15, fq = lane >> 4;
    const int K = g.K, nt = K / BK, lda = g.lda;
    unsigned voffA[2], voffB[2];
#pragma unroll
    for (int i = 0; i < 2; ++i) { int R, C; stage_rc(tid * 16 + i * 8192, R, C); const int Rb = Epi::PERM ? ((R & ~31) + perm32(R & 31)) : R;
        voffA[i] = (unsigned)(R * lda + C) * 2u; voffB[i] = (unsigned)(Rb * K + C) * 2u; }
    const size_t kstep = (size_t)(BK * 2);
    const size_t hstepA = (size_t)HALF * lda * 2, hstepB = (size_t)HALF * K * 2;
    const size_t tstepA = 2 * hstepA, tstepB = 2 * hstepB;
    const unsigned ldsw = (unsigned)wid * 1024u;
    const int aoff = lds_byte(wr * 64 + fr, fq * 8), boff = lds_byte(wc * 32 + fr, fq * 8);
#define PG8_SA(b, h) (((b) * 2 + (h)) * HTB)
#define PG8_SB(b, h) ((4 + (b) * 2 + (h)) * HTB)
#define PG8_STAGE(bufoff, gbase, voff) do { _Pragma("unroll") for (int _i = 0; _i < 2; ++_i) \
        __builtin_amdgcn_global_load_lds((const unsigned*)((const char*)(gbase) + (voff)[_i]), (LAS unsigned*)(lds + (bufoff) + ldsw + _i * 8192), 16, 0, 0); } while (0)
#define PG8_LDA(dst, b, h) do { _Pragma("unroll") for (int m = 0; m < 4; ++m) _Pragma("unroll") for (int k = 0; k < 2; ++k) dst[m][k] = *(const LAS bf16x8*)(lds + PG8_SA(b, h) + aoff + m * 2048 + k * 1024); } while (0)
#define PG8_LDB(dst, b, h) do { _Pragma("unroll") for (int n = 0; n < 2; ++n) _Pragma("unroll") for (int k = 0; k < 2; ++k) dst[n][k] = *(const LAS bf16x8*)(lds + PG8_SB(b, h) + boff + n * 2048 + k * 1024); } while (0)
#define PG8_MMA(ai, bj, At, Bt) do { __builtin_amdgcn_s_setprio(1); _Pragma("unroll") for (int m = 0; m < 4; ++m) _Pragma("unroll") for (int n = 0; n < 2; ++n) _Pragma("unroll") for (int k = 0; k < 2; ++k) \
        acc[ai][bj][m][n] = __builtin_amdgcn_mfma_f32_16x16x32_bf16(Bt[n][k], At[m][k], acc[ai][bj][m][n], 0, 0, 0); __builtin_amdgcn_s_setprio(0); } while (0)
#define PG8_WAIT_V(n) asm volatile("s_waitcnt vmcnt(" #n ")" ::: "memory")
#define PG8_WAIT_L(n) asm volatile("s_waitcnt lgkmcnt(" #n ")" ::: "memory")
#define PG8_BAR __builtin_amdgcn_s_barrier()
#define PG8_SCHED __builtin_amdgcn_sched_barrier(0)
    Unit cur, nxt; int ui = 0;
    if (!S.next(0, cur)) return;
    f32x4 acc[2][2][4][2];
#pragma unroll
    for (int a = 0; a < 2; ++a)
#pragma unroll
        for (int b = 0; b < 2; ++b)
#pragma unroll
            for (int m = 0; m < 4; ++m)
#pragma unroll
                for (int n = 0; n < 2; ++n) acc[a][b][m][n] = (f32x4){0.f, 0.f, 0.f, 0.f};
    bf16x8 At[4][2], B0[2][2], B1[2][2];
    const char* cA = (const char*)g.A + (size_t)cur.pm * tstepA; const char* cB = (const char*)g.Bt + (size_t)cur.pn * tstepB;
    PG8_STAGE(PG8_SB(0, 0), cB, voffB); PG8_STAGE(PG8_SB(0, 1), cB + hstepB, voffB); PG8_STAGE(PG8_SA(0, 0), cA, voffA); PG8_STAGE(PG8_SA(0, 1), cA + hstepA, voffA);
    if (wr == 1) PG8_BAR;
    PG8_WAIT_V(2); PG8_BAR;
    PG8_STAGE(PG8_SB(1, 0), cB + kstep, voffB); PG8_STAGE(PG8_SA(1, 0), cA + kstep, voffA); PG8_STAGE(PG8_SB(1, 1), cB + hstepB + kstep, voffB);
    PG8_WAIT_V(6); PG8_BAR;
    for (;;) {
        const bool has_next = S.next(ui + 1, nxt);
        const char* nA = has_next ? (const char*)g.A + (size_t)nxt.pm * tstepA : cA; const char* nB = has_next ? (const char*)g.Bt + (size_t)nxt.pn * tstepB : cB;
        for (int t = 0; t < nt; t += 2) {
            const bool last = (t == nt - 2);
            const char* a1 = cA + (size_t)(t + 1) * kstep;
            const char* a2 = last ? nA : cA + (size_t)(t + 2) * kstep; const char* b2 = last ? nB : cB + (size_t)(t + 2) * kstep;
            const char* a3 = a2 + kstep; const char* b3 = b2 + kstep;
            PG8_LDB(B0, 0, 0); PG8_LDB(B1, 0, 1); PG8_SCHED; PG8_LDA(At, 0, 0); PG8_STAGE(PG8_SA(1, 1), a1 + hstepA, voffA);
            PG8_WAIT_V(8); PG8_WAIT_L(0); PG8_BAR; PG8_MMA(0, 0, At, B0); PG8_MMA(0, 1, At, B1); PG8_BAR; PG8_SCHED;
            PG8_LDA(At, 0, 1); PG8_STAGE(PG8_SB(0, 0), b2, voffB); PG8_STAGE(PG8_SB(0, 1), b2 + hstepB, voffB); PG8_STAGE(PG8_SA(0, 0), a2, voffA);
            PG8_WAIT_V(8); PG8_WAIT_L(0); PG8_BAR; PG8_MMA(1, 0, At, B0); PG8_MMA(1, 1, At, B1); PG8_BAR; PG8_SCHED;
            PG8_LDB(B0, 1, 0); PG8_LDB(B1, 1, 1); PG8_SCHED; PG8_LDA(At, 1, 0); PG8_STAGE(PG8_SA(0, 1), a2 + hstepA, voffA);
            PG8_WAIT_V(8); PG8_WAIT_L(0); PG8_BAR; PG8_MMA(0, 0, At, B0); PG8_MMA(0, 1, At, B1); PG8_BAR; PG8_SCHED;
            PG8_LDA(At, 1, 1); PG8_STAGE(PG8_SB(1, 0), b3, voffB); PG8_STAGE(PG8_SB(1, 1), b3 + hstepB, voffB); PG8_STAGE(PG8_SA(1, 0), a3, voffA);
            PG8_WAIT_V(8); PG8_WAIT_L(0); PG8_BAR; PG8_MMA(1, 0, At, B0); PG8_MMA(1, 1, At, B1); PG8_BAR; PG8_SCHED;
        }
        if (wr == 0) PG8_BAR;
        E(acc, cur, wr, wc, fr, fq);
        if (!has_next) break;
#pragma unroll
        for (int a = 0; a < 2; ++a)
#pragma unroll
            for (int b = 0; b < 2; ++b)
#pragma unroll
                for (int m = 0; m < 4; ++m)
#pragma unroll
                    for (int n = 0; n < 2; ++n) acc[a][b][m][n] = (f32x4){0.f, 0.f, 0.f, 0.f};
        cur = nxt; cA = nA; cB = nB; ++ui;
        if (wr == 1) PG8_BAR;
    }
    PG8_WAIT_V(0);
    PG8_BAR;
#undef PG8_SA
#undef PG8_SB
#undef PG8_STAGE
#undef PG8_LDA
#undef PG8_LDB
#undef PG8_MMA
#undef PG8_WAIT_V
#undef PG8_WAIT_L
#undef PG8_BAR
#undef PG8_SCHED
}
}

typedef const f32x4 (&AccRef)[2][2][4][2];
__device__ __forceinline__ u32x4 pack8(f32x4 v0, f32x4 v1) { u32x4 w; w.x = cvt_pk_bf16(v0[0], v0[1]); w.y = cvt_pk_bf16(v0[2], v0[3]); w.z = cvt_pk_bf16(v1[0], v1[1]); w.w = cvt_pk_bf16(v1[2], v1[3]); return w; }
__device__ __forceinline__ float sumsq4(f32x4 v) { return (v[0] * v[0] + v[1] * v[1]) + (v[2] * v[2] + v[3] * v[3]); }

struct EpiIn {
    static constexpr bool PERM = true;
    bf16_t* QKV; bf16_t* CQKV; bf16_t* KR; float* ssq_q; float* ssq_kv; const float* tda; const float* tmla;
    __device__ __forceinline__ void operator()(AccRef acc, const pg8::Unit& u, int wr, int wc, int fr, int fq) const {
        const int pn = u.pn, row0 = u.pm * 256 + wr * 64 + fr, cl = wc * 32 + 8 * fq;
        if (pn < 12) {
            const bool rope = (pn < 8) && ((wc & 1) == 0) && (fq < 2);
#pragma unroll
            for (int ai = 0; ai < 2; ++ai)
#pragma unroll
                for (int m = 0; m < 4; ++m) {
                    const int row = row0 + ai * 128 + m * 16; const int pos = row < S0 ? row : row - S0;
                    f32x4 cs = (f32x4){1.f, 1.f, 1.f, 1.f}, sn = (f32x4){0.f, 0.f, 0.f, 0.f};
                    if (rope) { cs = *(const f32x4*)(tda + (size_t)pos * 16 + 4 * fq); sn = *(const f32x4*)(tda + (size_t)pos * 16 + 8 + 4 * fq); }
#pragma unroll
                    for (int bj = 0; bj < 2; ++bj) {
                        const f32x4 v0 = acc[ai][bj][m][0], v1 = acc[ai][bj][m][1];
                        const f32x4 o0 = v0 * cs - v1 * sn, o1 = v1 * cs + v0 * sn;
                        *(u32x4*)(QKV + (size_t)row * 3072 + pn * 256 + bj * 128 + cl) = rope ? pack8(o0, o1) : pack8(v0, v1);
                    }
                }
        } else if (pn < 16) {
            float* ssq = pn < 14 ? ssq_q : ssq_kv;
#pragma unroll
            for (int ai = 0; ai < 2; ++ai)
#pragma unroll
                for (int m = 0; m < 4; ++m) {
                    const int row = row0 + ai * 128 + m * 16; float s = 0.f;
#pragma unroll
                    for (int bj = 0; bj < 2; ++bj) {
                        const f32x4 v0 = acc[ai][bj][m][0], v1 = acc[ai][bj][m][1];
                        s += sumsq4(v0) + sumsq4(v1);
                        *(u32x4*)(CQKV + (size_t)row * 1024 + (pn - 12) * 256 + bj * 128 + cl) = pack8(v0, v1);
                    }
                    s += shx<16>(s); s = add_halves(s);
                    if (fq == 0) ssq[(size_t)row * 8 + (pn & 1) * 4 + wc] = s;
                }
        } else {
            if (wc < 2) {
                const int g4 = 4 * (4 * wc + fq);
#pragma unroll
                for (int ai = 0; ai < 2; ++ai)
#pragma unroll
                    for (int m = 0; m < 4; ++m) {
                        const int row = row0 + ai * 128 + m * 16; const int pos = row < S0 ? row : row - S0;
                        const f32x4 cs = *(const f32x4*)(tmla + (size_t)pos * 64 + g4), sn = *(const f32x4*)(tmla + (size_t)pos * 64 + 32 + g4);
                        const f32x4 v0 = acc[ai][0][m][0], v1 = acc[ai][0][m][1];
                        const f32x4 o0 = v0 * cs - v1 * sn, o1 = v1 * cs + v0 * sn;
                        *(u32x4*)(KR + (size_t)row * 64 + cl) = pack8(o0, o1);
                    }
            }
        }
    }
};
struct EpiQb {
    static constexpr bool PERM = true;
    bf16_t* QM; const float* ssq_q; const float* tmla;
    __device__ __forceinline__ void operator()(AccRef acc, const pg8::Unit& u, int wr, int wc, int fr, int fq) const {
        const int pn = u.pn, row0 = u.pm * 256 + wr * 64 + fr, cl = wc * 32 + 8 * fq;
        const int g4 = 4 * (4 * (wc & 1) + fq);
        const bool rp0 = ((pn * 4 + 0 + (wc >> 1)) % 3) == 2, rp1 = ((pn * 4 + 2 + (wc >> 1)) % 3) == 2;
#pragma unroll
        for (int ai = 0; ai < 2; ++ai)
#pragma unroll
            for (int m = 0; m < 4; ++m) {
                const int row = row0 + ai * 128 + m * 16; const int pos = row < S0 ? row : row - S0;
                const f32x4 sa = *(const f32x4*)(ssq_q + (size_t)row * 8), sb = *(const f32x4*)(ssq_q + (size_t)row * 8 + 4);
                const float rs = rsqrtf((((sa[0] + sa[1]) + (sa[2] + sa[3])) + ((sb[0] + sb[1]) + (sb[2] + sb[3]))) * (1.0f / 512.0f) + EPS);
                f32x4 cs = (f32x4){1.f, 1.f, 1.f, 1.f}, sn = (f32x4){0.f, 0.f, 0.f, 0.f};
                if (rp0 || rp1) { cs = *(const f32x4*)(tmla + (size_t)pos * 64 + g4); sn = *(const f32x4*)(tmla + (size_t)pos * 64 + 32 + g4); }
#pragma unroll
                for (int bj = 0; bj < 2; ++bj) {
                    const bool rp = bj ? rp1 : rp0;
                    const f32x4 v0 = acc[ai][bj][m][0] * rs, v1 = acc[ai][bj][m][1] * rs;
                    const f32x4 o0 = v0 * cs - v1 * sn, o1 = v1 * cs + v0 * sn;
                    *(u32x4*)(QM + (size_t)row * 1536 + pn * 256 + bj * 128 + cl) = rp ? pack8(o0, o1) : pack8(v0, v1);
                }
            }
    }
};
struct EpiScale {
    static constexpr bool PERM = true;
    bf16_t* O; int ldo; const float* ssq; float inv_n;
    __device__ __forceinline__ void operator()(AccRef acc, const pg8::Unit& u, int wr, int wc, int fr, int fq) const {
        const int pn = u.pn, row0 = u.pm * 256 + wr * 64 + fr, cl = wc * 32 + 8 * fq;
#pragma unroll
        for (int ai = 0; ai < 2; ++ai)
#pragma unroll
            for (int m = 0; m < 4; ++m) {
                const int row = row0 + ai * 128 + m * 16;
                const f32x4 sa = *(const f32x4*)(ssq + (size_t)row * 8), sb = *(const f32x4*)(ssq + (size_t)row * 8 + 4);
                const float rs = rsqrtf((((sa[0] + sa[1]) + (sa[2] + sa[3])) + ((sb[0] + sb[1]) + (sb[2] + sb[3]))) * inv_n + EPS);
#pragma unroll
                for (int bj = 0; bj < 2; ++bj)
                    *(u32x4*)(O + (size_t)row * ldo + pn * 256 + bj * 128 + cl) = pack8(acc[ai][bj][m][0] * rs, acc[ai][bj][m][1] * rs);
            }
    }
};
__device__ __forceinline__ void unpack8(u32x4 w, f32x4& a, f32x4& b) { a = (f32x4){bf_lo(w.x), bf_hi(w.x), bf_lo(w.y), bf_hi(w.y)}; b = (f32x4){bf_lo(w.z), bf_hi(w.z), bf_lo(w.w), bf_hi(w.w)}; }
struct EpiPlain {
    static constexpr bool PERM = true;
    bf16_t* O; int ldo;
    __device__ __forceinline__ void operator()(AccRef acc, const pg8::Unit& u, int wr, int wc, int fr, int fq) const {
        const int pn = u.pn, row0 = u.pm * 256 + wr * 64 + fr, cl = wc * 32 + 8 * fq;
#pragma unroll
        for (int ai = 0; ai < 2; ++ai)
#pragma unroll
            for (int m = 0; m < 4; ++m) {
                const int row = row0 + ai * 128 + m * 16;
#pragma unroll
                for (int bj = 0; bj < 2; ++bj) *(u32x4*)(O + (size_t)row * ldo + pn * 256 + bj * 128 + cl) = pack8(acc[ai][bj][m][0], acc[ai][bj][m][1]);
            }
    }
};
template <int MODE> struct EpiGate {
    static constexpr bool PERM = true;
    bf16_t* MRG; const bf16_t* TMP;
    __device__ __forceinline__ void operator()(AccRef acc, const pg8::Unit& u, int wr, int wc, int fr, int fq) const {
        const int pn = u.pn, row0 = u.pm * 256 + wr * 64 + fr, cl = wc * 32 + 8 * fq;
#pragma unroll
        for (int ai = 0; ai < 2; ++ai)
#pragma unroll
            for (int m = 0; m < 4; ++m) {
                const int row = row0 + ai * 128 + m * 16;
#pragma unroll
                for (int bj = 0; bj < 2; ++bj) {
                    const size_t off = (size_t)row * 2048 + pn * 256 + bj * 128 + cl;
                    f32x4 g0 = acc[ai][bj][m][0], g1 = acc[ai][bj][m][1];
#pragma unroll
                    for (int e = 0; e < 4; ++e) { g0[e] = sigmoidf_(g0[e]); g1[e] = sigmoidf_(g1[e]); }
                    f32x4 m0, m1; unpack8(*(const u32x4*)(MRG + off), m0, m1);
                    if (MODE == 0) { m0 = m0 * g0; m1 = m1 * g1; }
                    else { f32x4 t0, t1; unpack8(*(const u32x4*)(TMP + off), t0, t1); m0 = m0 + g0 * t0; m1 = m1 + g1 * t1; }
                    *(u32x4*)(MRG + off) = pack8(m0, m1);
                }
            }
    }
};
struct EpiX1 {
    static constexpr bool PERM = true;
    const float* x0; const float* x1; bf16_t* XB;
    __device__ __forceinline__ void operator()(AccRef acc, const pg8::Unit& u, int wr, int wc, int fr, int fq) const {
        const int pn = u.pn, row0 = u.pm * 256 + wr * 64 + fr, cl = wc * 32 + 8 * fq;
#pragma unroll
        for (int ai = 0; ai < 2; ++ai)
#pragma unroll
            for (int m = 0; m < 4; ++m) {
                const int row = row0 + ai * 128 + m * 16;
                const float* xr = row < S0 ? x0 + (size_t)row * DM : x1 + (size_t)(row - S0) * DM;
#pragma unroll
                for (int bj = 0; bj < 2; ++bj) {
                    const int col = pn * 256 + bj * 128 + cl;
                    const f32x4 a0 = *(const f32x4*)(xr + col) + acc[ai][bj][m][0], a1 = *(const f32x4*)(xr + col + 4) + acc[ai][bj][m][1];
                    *(u32x4*)(XB + (size_t)row * DM + col) = pack8(a0, a1);
                }
            }
    }
};
struct EpiX2 {
    static constexpr bool PERM = true;
    bf16_t* XB;
    __device__ __forceinline__ void operator()(AccRef acc, const pg8::Unit& u, int wr, int wc, int fr, int fq) const {
        const int pn = u.pn, row0 = u.pm * 256 + wr * 64 + fr, cl = wc * 32 + 8 * fq;
#pragma unroll
        for (int ai = 0; ai < 2; ++ai)
#pragma unroll
            for (int m = 0; m < 4; ++m) {
                const int row = row0 + ai * 128 + m * 16;
#pragma unroll
                for (int bj = 0; bj < 2; ++bj) {
                    const size_t off = (size_t)row * DM + pn * 256 + bj * 128 + cl;
                    f32x4 m0, m1; unpack8(*(const u32x4*)(XB + off), m0, m1);
                    *(u32x4*)(XB + off) = pack8(m0 + acc[ai][bj][m][0], m1 + acc[ai][bj][m][1]);
                }
            }
    }
};
struct EpiSwiGLU {
    static constexpr bool PERM = true;
    bf16_t* ACT; const float* rstd;
    __device__ __forceinline__ void operator()(AccRef acc, const pg8::Unit& u, int wr, int wc, int fr, int fq) const {
        const int pn = u.pn, row0 = u.pm * 256 + wr * 64 + fr, cl = wc * 32 + 8 * fq;
#pragma unroll
        for (int ai = 0; ai < 2; ++ai)
#pragma unroll
            for (int m = 0; m < 4; ++m) {
                const int row = row0 + ai * 128 + m * 16;
                const float rs = rstd[row];
                f32x4 a[2];
#pragma unroll
                for (int n = 0; n < 2; ++n) { const f32x4 gt = acc[ai][0][m][n] * rs, up = acc[ai][1][m][n] * rs;
#pragma unroll
                    for (int e = 0; e < 4; ++e) a[n][e] = gt[e] * sigmoidf_(gt[e]) * up[e]; }
                *(u32x4*)(ACT + (size_t)row * FF + pn * 128 + cl) = pack8(a[0], a[1]);
            }
    }
};

namespace att {
constexpr int KVBLK = 64, SHM_V = 16384, SHM_K = 16384, SHM_KR = 8192;
#define KSWZ(row, colB) ((row) * 256 + ((colB) ^ (((row) & 15) << 4)))
#define KRSWZ(row, colB) ((row) * 128 + ((colB) ^ ((((row) >> 1) & 7) << 4)))
#define SBAR() __builtin_amdgcn_sched_barrier(0)
__device__ __forceinline__ int crow(int r, int hi) { return (r & 3) + 8 * (r >> 2) + 4 * hi; }
template <int MODE> struct Cst { static constexpr float SCALE = MODE ? 0.07216878364870322f : 0.125f; static constexpr float C = SCALE * LOG2E; static constexpr float THRS = 8.0f / SCALE; };

template <int MODE> __device__ __forceinline__ void partialSM(f32x16& p0, f32x16& p1, float& m_reg, float& mn, float& alpha) {
    constexpr float C = Cst<MODE>::C;
    float pmax = p0[0];
#pragma unroll
    for (int r = 1; r < 16; ++r) pmax = fmaxf(pmax, p0[r]);
#pragma unroll
    for (int r = 0; r < 16; ++r) pmax = fmaxf(pmax, p1[r]);
    { auto rr = __builtin_amdgcn_permlane32_swap(__float_as_uint(pmax), __float_as_uint(pmax), false, false);
      pmax = fmaxf(__uint_as_float(rr[0]), __uint_as_float(rr[1])); }
    if (__builtin_expect(__all(pmax - m_reg <= Cst<MODE>::THRS), 1)) { mn = m_reg; alpha = 1.f; }
    else { mn = fmaxf(m_reg, pmax); alpha = __builtin_amdgcn_exp2f((m_reg - mn) * C); m_reg = mn; }
    const float mnC = -mn * C;
#pragma unroll
    for (int r = 0; r < 16; ++r) p0[r] = fmaf(p0[r], C, mnC);
#pragma unroll
    for (int r = 0; r < 16; ++r) p1[r] = fmaf(p1[r], C, mnC);
#pragma unroll
    for (int r = 0; r < 16; ++r) p0[r] = __builtin_amdgcn_exp2f(p0[r]);
}
__device__ __forceinline__ void finishSM(f32x16& p0, f32x16& p1, float alpha, float& l_reg, bf16x8& pa0, bf16x8& pa1, bf16x8& pa2, bf16x8& pa3) {
#pragma unroll
    for (int r = 0; r < 16; ++r) p1[r] = __builtin_amdgcn_exp2f(p1[r]);
    typedef float f32x2 __attribute__((ext_vector_type(2)));
    f32x2 s2 = (f32x2){p0[0], p0[1]};
#pragma unroll
    for (int r = 2; r < 16; r += 2) s2 += (f32x2){p0[r], p0[r + 1]};
#pragma unroll
    for (int r = 0; r < 16; r += 2) s2 += (f32x2){p1[r], p1[r + 1]};
    float ps = s2.x + s2.y;
    { auto rr = __builtin_amdgcn_permlane32_swap(__float_as_uint(ps), __float_as_uint(ps), false, false);
      ps = __uint_as_float(rr[0]) + __uint_as_float(rr[1]); }
    l_reg = l_reg * alpha + ps;
#define PK4(P, BASE, OUT) do { unsigned a0 = cvt_pk_bf16(P[BASE + 0], P[BASE + 1]), a1 = cvt_pk_bf16(P[BASE + 2], P[BASE + 3]);   \
    unsigned b0 = cvt_pk_bf16(P[BASE + 4], P[BASE + 5]), b1 = cvt_pk_bf16(P[BASE + 6], P[BASE + 7]);                              \
    auto r0 = __builtin_amdgcn_permlane32_swap(a0, b0, false, false); auto r1 = __builtin_amdgcn_permlane32_swap(a1, b1, false, false); \
    u32x4 w = {r0[0], r1[0], r0[1], r1[1]}; OUT = *reinterpret_cast<bf16x8*>(&w); } while (0)
    PK4(p0, 0, pa0); PK4(p0, 8, pa1); PK4(p1, 0, pa2); PK4(p1, 8, pa3);
#undef PK4
}
template <int MODE> __device__ __forceinline__ void qkt(f32x16& p0, f32x16& p1, const LAS unsigned char* Kt, const LAS unsigned char* Krt, const bf16x8* qr, int r32, int hi, int comp) {
    p0 = f32x16{}; p1 = f32x16{};
    constexpr int NDN = MODE ? 8 : 4;
#pragma unroll
    for (int d0 = 0; d0 < NDN; ++d0) { const int cb = ((MODE ? 0 : comp * 64) + d0 * 16 + hi * 8) * 2;
        const bf16x8 b0 = *(const LAS bf16x8*)(Kt + KSWZ(r32, cb));
        const bf16x8 b1 = *(const LAS bf16x8*)(Kt + KSWZ(32 + r32, cb));
        p0 = __builtin_amdgcn_mfma_f32_32x32x16_bf16(b0, qr[d0], p0, 0, 0, 0);
        p1 = __builtin_amdgcn_mfma_f32_32x32x16_bf16(b1, qr[d0], p1, 0, 0, 0); }
    if constexpr (MODE == 1) {
#pragma unroll
        for (int d0 = 0; d0 < 4; ++d0) { const int cb = (d0 * 16 + hi * 8) * 2;
            const bf16x8 b0 = *(const LAS bf16x8*)(Krt + KRSWZ(r32, cb));
            const bf16x8 b1 = *(const LAS bf16x8*)(Krt + KRSWZ(32 + r32, cb));
            p0 = __builtin_amdgcn_mfma_f32_32x32x16_bf16(b0, qr[8 + d0], p0, 0, 0, 0);
            p1 = __builtin_amdgcn_mfma_f32_32x32x16_bf16(b1, qr[8 + d0], p1, 0, 0, 0); }
    }
}
__device__ __forceinline__ int v_st(int k, int c) { const int kk = (k & ~0xC) | ((k & 4) << 1) | ((k & 8) >> 1); return ((kk >> 3) * 4 + (c >> 5)) * 512 + ((kk & 7) * 32 + (c & 31)) * 2; }
__device__ __forceinline__ int v_rd_base(int lane) { return ((lane & 3) << 3) | (((lane >> 2) & 3) << 6) | (((lane >> 4) & 1) << 5) | (((lane >> 5) & 1) << 8); }
constexpr int v_rd_off(int d0, int ks, int half) { return d0 * 512 + ks * 4096 + half * 2048; }
template <int OFF> __device__ __forceinline__ s16x4 tr_read(int vb) {
    s16x4 r; asm volatile("ds_read_b64_tr_b16 %0, %1 offset:%2" : "=&v"(r) : "v"(vb), "i"(OFF) : "memory"); return r;
}
template <int D0> __device__ __forceinline__ void pv_one(f32x16& od, int vb, bf16x8 pa0, bf16x8 pa1, bf16x8 pa2, bf16x8 pa3) {
    const s16x4 l0 = tr_read<v_rd_off(D0, 0, 0)>(vb), h0 = tr_read<v_rd_off(D0, 0, 1)>(vb), l1 = tr_read<v_rd_off(D0, 1, 0)>(vb), h1 = tr_read<v_rd_off(D0, 1, 1)>(vb);
    const s16x4 l2 = tr_read<v_rd_off(D0, 2, 0)>(vb), h2 = tr_read<v_rd_off(D0, 2, 1)>(vb), l3 = tr_read<v_rd_off(D0, 3, 0)>(vb), h3 = tr_read<v_rd_off(D0, 3, 1)>(vb);
    asm volatile("s_waitcnt lgkmcnt(0)" ::: "memory"); SBAR();
#define PK(L, H) (bf16x8){L[0], L[1], L[2], L[3], H[0], H[1], H[2], H[3]}
    od = __builtin_amdgcn_mfma_f32_32x32x16_bf16(pa0, PK(l0, h0), od, 0, 0, 0);
    od = __builtin_amdgcn_mfma_f32_32x32x16_bf16(pa1, PK(l1, h1), od, 0, 0, 0);
    od = __builtin_amdgcn_mfma_f32_32x32x16_bf16(pa2, PK(l2, h2), od, 0, 0, 0);
    od = __builtin_amdgcn_mfma_f32_32x32x16_bf16(pa3, PK(l3, h3), od, 0, 0, 0);
#undef PK
}
__device__ __forceinline__ void pv_d0(f32x16* o, int vb, bf16x8 pa0, bf16x8 pa1, bf16x8 pa2, bf16x8 pa3) {
    pv_one<0>(o[0], vb, pa0, pa1, pa2, pa3); pv_one<1>(o[1], vb, pa0, pa1, pa2, pa3); pv_one<2>(o[2], vb, pa0, pa1, pa2, pa3); pv_one<3>(o[3], vb, pa0, pa1, pa2, pa3);
}
struct VFrag { s16x4 l0, h0, l1, h1, l2, h2, l3, h3; };
template <int D0> __device__ __forceinline__ void v_frag_read(VFrag& f, int vb) {
    f.l0 = tr_read<v_rd_off(D0, 0, 0)>(vb); f.h0 = tr_read<v_rd_off(D0, 0, 1)>(vb); f.l1 = tr_read<v_rd_off(D0, 1, 0)>(vb); f.h1 = tr_read<v_rd_off(D0, 1, 1)>(vb);
    f.l2 = tr_read<v_rd_off(D0, 2, 0)>(vb); f.h2 = tr_read<v_rd_off(D0, 2, 1)>(vb); f.l3 = tr_read<v_rd_off(D0, 3, 0)>(vb); f.h3 = tr_read<v_rd_off(D0, 3, 1)>(vb);
}
__device__ __forceinline__ void pv_mma(f32x16& od, const VFrag& f, bf16x8 pa0, bf16x8 pa1, bf16x8 pa2, bf16x8 pa3) {
#define PK(L, H) (bf16x8){L[0], L[1], L[2], L[3], H[0], H[1], H[2], H[3]}
    od = __builtin_amdgcn_mfma_f32_32x32x16_bf16(pa0, PK(f.l0, f.h0), od, 0, 0, 0);
    od = __builtin_amdgcn_mfma_f32_32x32x16_bf16(pa1, PK(f.l1, f.h1), od, 0, 0, 0);
    od = __builtin_amdgcn_mfma_f32_32x32x16_bf16(pa2, PK(f.l2, f.h2), od, 0, 0, 0);
    od = __builtin_amdgcn_mfma_f32_32x32x16_bf16(pa3, PK(f.l3, f.h3), od, 0, 0, 0);
#undef PK
}
#define LW(n) asm volatile("s_waitcnt lgkmcnt(" #n ")" ::: "memory")
template <int MODE, bool PF> __device__ __forceinline__ void pv_partial(f32x16* o, int vb, bf16x8 pa0, bf16x8 pa1, bf16x8 pa2, bf16x8 pa3, f32x16& p0, f32x16& p1, float& m_reg, float& alpha) {
    constexpr float C = Cst<MODE>::C;
    VFrag fa, fb;
    v_frag_read<0>(fa, vb);
    if constexpr (PF) { v_frag_read<1>(fb, vb); LW(8); } else LW(0);
    SBAR();
    pv_mma(o[0], fa, pa0, pa1, pa2, pa3);
    float pm0 = p0[0];
#pragma unroll
    for (int r = 1; r < 16; ++r) pm0 = fmaxf(pm0, p0[r]);
    if constexpr (PF) { v_frag_read<2>(fa, vb); LW(8); } else { v_frag_read<1>(fb, vb); LW(0); }
    SBAR();
    pv_mma(o[1], fb, pa0, pa1, pa2, pa3);
    float pmax = pm0;
#pragma unroll
    for (int r = 0; r < 16; ++r) pmax = fmaxf(pmax, p1[r]);
    { auto rr = __builtin_amdgcn_permlane32_swap(__float_as_uint(pmax), __float_as_uint(pmax), false, false);
      pmax = fmaxf(__uint_as_float(rr[0]), __uint_as_float(rr[1])); }
    const float mn = (pmax - m_reg > Cst<MODE>::THRS) ? fmaxf(m_reg, pmax) : m_reg;
    alpha = __builtin_amdgcn_exp2f((m_reg - mn) * C); m_reg = mn;
    const float mnC = -mn * C;
    if constexpr (PF) { v_frag_read<3>(fb, vb); LW(8); } else { v_frag_read<2>(fa, vb); LW(0); }
    SBAR();
    pv_mma(o[2], fa, pa0, pa1, pa2, pa3);
#pragma unroll
    for (int r = 0; r < 16; ++r) p0[r] = fmaf(p0[r], C, mnC);
#pragma unroll
    for (int r = 0; r < 16; ++r) p1[r] = fmaf(p1[r], C, mnC);
#pragma unroll
    for (int r = 0; r < 8; ++r) p0[r] = __builtin_amdgcn_exp2f(p0[r]);
    if constexpr (PF) { LW(0); } else { v_frag_read<3>(fb, vb); LW(0); }
    SBAR();
    pv_mma(o[3], fb, pa0, pa1, pa2, pa3);
#pragma unroll
    for (int r = 8; r < 16; ++r) p0[r] = __builtin_amdgcn_exp2f(p0[r]);
    asm volatile("" : "+v"(p0), "+v"(p1));
}
#undef LW
__device__ __forceinline__ bf16_t f2bf(float f) { return (bf16_t)(cvt_pk_bf16(f, f) & 0xffffu); }

template <int MODE, bool STORE = true>
__device__ __forceinline__ void attn_unit(LAS unsigned char* lds, const bf16_t* Qb, const bf16_t* __restrict__ Kh, const bf16_t* __restrict__ Krh, const bf16_t* __restrict__ Vh,
                                          int seq, bf16_t* Ob, float lam, const float* __restrict__ subg, int wv) {
    constexpr int ND = MODE ? 12 : 4, LDQ = MODE ? 1536 : 3072, LDK = MODE ? 2048 : 3072, LDO = MODE ? 1024 : 3072;
    constexpr bool PFV = (MODE == 0);
    constexpr int STG = SHM_V + SHM_K + (MODE ? SHM_KR : 0), OFF_WS = 3 * STG;
    int tid = wv * 64 + lane_id(); asm volatile("" : "+v"(tid));
    const int wid = __builtin_amdgcn_readfirstlane(tid >> 6), lane = tid & 63, r32 = lane & 31, hi = lane >> 5;
    const int comp = MODE ? 0 : (wid >> 2), wq = MODE ? wid : (wid & 3);
    LAS float* wsf = (LAS float*)(lds + OFF_WS) + wid * 64; LAS float* li_l = wsf; LAS float* al_l = wsf + 32;
    float m_reg = -1e30f, l_reg = 0; f32x16 o[4] = {}; bf16x8 qr[ND];
    const bf16_t* Qw = Qb + (size_t)(wq * 32 + r32) * LDQ + comp * 64 + hi * 8;
#pragma unroll
    for (int d0 = 0; d0 < ND; ++d0) qr[d0] = *(const bf16x8*)(Qw + d0 * 16);
    const int sr = tid >> 4, sc = (tid & 15) * 8, vst0 = v_st(sr, sc), vst1 = v_st(32 + sr, sc);
    const int krr = tid >> 3, krc = (tid & 7) * 8;
    const int vb0 = (int)(unsigned)(uintptr_t)lds + v_rd_base(lane);
    struct Slot { bf16x8 vs0, vs1, ks0, ks1, kr; } sl;
#define SLOAD(k0) do { sl.vs0 = *(const bf16x8*)(Vh + (size_t)((k0) + sr) * LDK + sc); sl.vs1 = *(const bf16x8*)(Vh + (size_t)((k0) + 32 + sr) * LDK + sc); \
    sl.ks0 = *(const bf16x8*)(Kh + (size_t)((k0) + sr) * LDK + sc); sl.ks1 = *(const bf16x8*)(Kh + (size_t)((k0) + 32 + sr) * LDK + sc); \
    if constexpr (MODE == 1) sl.kr = *(const bf16x8*)(Krh + (size_t)((k0) + krr) * 64 + krc); } while (0)
#define SWRITE(so) do { *(LAS bf16x8*)(lds + (so) + vst0) = sl.vs0; *(LAS bf16x8*)(lds + (so) + vst1) = sl.vs1; \
    *(LAS bf16x8*)(lds + (so) + SHM_V + KSWZ(sr, sc * 2)) = sl.ks0; *(LAS bf16x8*)(lds + (so) + SHM_V + KSWZ(32 + sr, sc * 2)) = sl.ks1; \
    if constexpr (MODE == 1) *(LAS bf16x8*)(lds + (so) + SHM_V + SHM_K + KRSWZ(krr, krc * 2)) = sl.kr; } while (0)
#define RESC(a) do { if (__any((a) < 1.f)) { if (hi == 0) al_l[r32] = (a); asm volatile("s_waitcnt lgkmcnt(0)" ::: "memory"); \
    _Pragma("unroll") for (int d = 0; d < 4; ++d) _Pragma("unroll") for (int r = 0; r < 16; ++r) o[d][r] *= al_l[crow(r, hi)]; } } while (0)
#define KB(so) (lds + (so) + SHM_V)
#define KRB(so) (lds + (so) + SHM_V + SHM_K)
#define LBAR() asm volatile("s_waitcnt lgkmcnt(0)\n\ts_barrier" ::: "memory")
#define ROT() do { const int t_ = s_prev; s_prev = s_cur; s_cur = s_next; s_next = t_; } while (0)
#define ITER(jj, PC0, PC1, alC, PP0, PP1, alP) do { \
    if ((jj) + 1 < NT) SWRITE(s_next); \
    if ((jj) + 2 < NT) SLOAD(((jj) + 2) * KVBLK); \
    SBAR(); qkt<MODE>(PC0, PC1, KB(s_cur), KRB(s_cur), qr, r32, hi, comp); \
    finishSM(PP0, PP1, alP, l_reg, pa0, pa1, pa2, pa3); SBAR(); \
    pv_partial<MODE, PFV>(o, vb0 + s_prev, pa0, pa1, pa2, pa3, PC0, PC1, m_reg, alC); \
    RESC(alC); LBAR(); ROT(); } while (0)
    f32x16 pA0, pA1, pB0, pB1; float mnA, alA, alB; bf16x8 pa0, pa1, pa2, pa3; const int NT = seq / KVBLK;
    int s_prev = 0, s_cur = STG, s_next = 2 * STG;
    SLOAD(0); SWRITE(0); SLOAD(KVBLK); LBAR();
    SWRITE(STG); if (2 < NT) SLOAD(2 * KVBLK);
    qkt<MODE>(pA0, pA1, KB(0), KRB(0), qr, r32, hi, comp); partialSM<MODE>(pA0, pA1, m_reg, mnA, alA);
    LBAR();
    int j = 1;
    for (; j + 2 < NT; j += 2) {
        ITER(j, pB0, pB1, alB, pA0, pA1, alA);
        ITER(j + 1, pA0, pA1, alA, pB0, pB1, alB);
    }
    SBAR(); qkt<MODE>(pB0, pB1, KB(s_cur), KRB(s_cur), qr, r32, hi, comp);
    finishSM(pA0, pA1, alA, l_reg, pa0, pa1, pa2, pa3); SBAR();
    pv_partial<MODE, PFV>(o, vb0 + s_prev, pa0, pa1, pa2, pa3, pB0, pB1, m_reg, alB);
    RESC(alB);
    finishSM(pB0, pB1, alB, l_reg, pa0, pa1, pa2, pa3); SBAR();
    pv_d0(o, vb0 + s_cur, pa0, pa1, pa2, pa3);
    if (hi == 0) li_l[r32] = l_reg; asm volatile("s_waitcnt lgkmcnt(0)" ::: "memory");
    float rli[16];
#pragma unroll
    for (int r = 0; r < 16; ++r) rli[r] = __builtin_amdgcn_rcpf(li_l[crow(r, hi)]);
    if constexpr (MODE == 1) {
        bf16_t* Ow = Ob + (size_t)(wq * 32) * LDO;
#pragma unroll
        for (int r = 0; r < 16; ++r) { const int orow = crow(r, hi);
#pragma unroll
            for (int d0 = 0; d0 < 4; ++d0) Ow[(size_t)orow * LDO + d0 * 32 + r32] = f2bf(o[d0][r] * rli[r]); }
        __syncthreads();
    } else {
        __syncthreads();
        LAS float* X = (LAS float*)lds + (size_t)wq * 4096 + lane;
        if (comp == 1) {
#pragma unroll
            for (int d0 = 0; d0 < 4; ++d0)
#pragma unroll
                for (int r = 0; r < 16; ++r) X[(d0 * 16 + r) * 64] = o[d0][r] * rli[r];
        }
        __syncthreads();
        if (comp == 0) {
            float ss[16];
#pragma unroll
            for (int r = 0; r < 16; ++r) { float s = 0.f;
#pragma unroll
                for (int d0 = 0; d0 < 4; ++d0) { const float v = o[d0][r] * rli[r] - lam * X[(d0 * 16 + r) * 64]; o[d0][r] = v; s += v * v; }
                ss[r] = s; }
#pragma unroll
            for (int r = 0; r < 16; ++r) { float s = ss[r];
                s += shx<1>(s); s += shx<2>(s); s += shx<4>(s); s += shx<8>(s); s += shx<16>(s);
                ss[r] = rsqrtf(s * (1.0f / 128.0f) + EPS) * 0.8f; }
            float gg[4];
#pragma unroll
            for (int d0 = 0; d0 < 4; ++d0) gg[d0] = subg[d0 * 32 + r32];
            bf16_t* Ow = Ob + (size_t)(wq * 32) * LDO;
#pragma unroll
            for (int r = 0; r < 16; ++r) { const int orow = crow(r, hi);
#pragma unroll
                for (int d0 = 0; d0 < 4; ++d0) { const bf16_t val = f2bf(o[d0][r] * ss[r] * gg[d0]); if (STORE || val == 0x7fc1) Ow[(size_t)orow * LDO + d0 * 32 + r32] = val; } }
        }
        __syncthreads();
    }
#undef SLOAD
#undef SWRITE
#undef RESC
#undef KB
#undef KRB
#undef LBAR
#undef ROT
#undef ITER
}
}

struct ColSrc { const float* p; int ld; };
template <class Map>
__device__ __forceinline__ void transpose_items(const Map mp, int K, int Nout, bf16_t* WT, const float* gain, LAS float* scr, int gw, int ngw, int lane) {
    const int nblk = Nout / 32, nitems = (K / 64) * nblk;
    for (int it = gw; it < nitems; it += ngw) {
        const int kb = it / nblk, nb = it % nblk, k0 = 64 * kb, n0 = 32 * nb;
        const ColSrc cs = mp(n0 + (lane & 31));
#pragma unroll 8
        for (int i = 0; i < 32; ++i) { const int kk = 2 * i + (lane >> 5);
            float v = cs.p ? cs.p[(size_t)(k0 + kk) * cs.ld] : 0.f; if (gain) v *= gain[k0 + kk];
            scr[kk * 33 + (lane & 31)] = v; }
        asm volatile("s_waitcnt lgkmcnt(0)" ::: "memory");
        const int c = lane & 7;
#pragma unroll
        for (int j = 0; j < 4; ++j) { const int n = (lane >> 3) + 8 * j; const LAS float* s = scr + (8 * c) * 33 + n;
            u32x4 o; o.x = cvt_pk_bf16(s[0 * 33], s[1 * 33]); o.y = cvt_pk_bf16(s[2 * 33], s[3 * 33]); o.z = cvt_pk_bf16(s[4 * 33], s[5 * 33]); o.w = cvt_pk_bf16(s[6 * 33], s[7 * 33]);
            *(u32x4*)(WT + (size_t)(n0 + n) * K + k0 + 8 * c) = o; }
        asm volatile("s_waitcnt lgkmcnt(0)" ::: "memory");
    }
}
__device__ __forceinline__ int rope_src(int j, int ng) { const int g = j >> 3; if (g >= ng) return j; return ((j & 7) < 4 ? 0 : 4 * ng) + 4 * g + (j & 3); }
struct MapIn { const float* w;
    __device__ ColSrc operator()(int n) const {
        int src;
        if (n < 2048) src = (n & ~63) + rope_src(n & 63, 2);
        else if (n < 4096) src = n;
        else if (n < 4160) src = 4096 + rope_src(n - 4096, 8);
        else return ColSrc{nullptr, 0};
        return ColSrc{w + src, 8256}; } };
struct MapG { const float* w;
    __device__ ColSrc operator()(int n) const { return ColSrc{w + 4160 + n, 8256}; } };
struct MapQb { const float* w;
    __device__ ColSrc operator()(int n) const { const int blk = n >> 6; const int src = (blk % 3 == 2) ? (n & ~63) + rope_src(n & 63, 8) : n; return ColSrc{w + src, 1536}; } };
struct MapId { const float* w; int ld;
    __device__ ColSrc operator()(int n) const { return ColSrc{w + n, ld}; } };
struct MapGu { const float* wg; const float* wu;
    __device__ ColSrc operator()(int n) const { const int t = n >> 8, r = n & 255; return r < 128 ? ColSrc{wg + t * 128 + r, FF} : ColSrc{wu + t * 128 + (r - 128), FF}; } };

struct Args {
    const float* in[21]; float* out; unsigned char* ws;
};
constexpr int NWAVES = 8;
constexpr int LDS_BYTES = 147456;

__global__ void __launch_bounds__(NWAVES * 64, 2) fwd_mega(Args a) {
    extern __shared__ __attribute__((aligned(16))) unsigned char lds_raw[];
    LAS unsigned char* lds = (LAS unsigned char*)lds_raw;
    cg::grid_group grid = cg::this_grid();
    const int G = gridDim.x, bx = blockIdx.x;
    const int wv = __builtin_amdgcn_readfirstlane((int)threadIdx.x >> 6);
    volatile LAS unsigned* bst = (volatile LAS unsigned*)(lds + 139264);
    if (threadIdx.x < 2) bst[threadIdx.x] = 0u;
    const int vcu = (G % 8 == 0) ? (bx % 8) * (G / 8) + bx / 8 : bx;
#define PHASE_PTRS() \
    size_t zoff_ = 0; asm volatile("" : "+s"(zoff_)); unsigned char* ws = a.ws + zoff_; \
    int tid = wv * 64 + lane_id(); asm volatile("" : "+v"(tid)); const int lane = tid & 63, wave = wv; (void)lane; (void)wave; \
    const int gw = vcu * NWAVES + wave, ngw = G * NWAVES; (void)gw; (void)ngw; \
    const float* x0 = a.in[0]; const float* x1 = a.in[1]; (void)x0; (void)x1; \
    float* ssq_q = (float*)(ws + WS_SSQ); float* ssq_kv = (float*)(ws + WS_SSQ + MiB); float* rstd1 = (float*)(ws + WS_RSTD); (void)ssq_q; (void)ssq_kv; (void)rstd1; \
    float* tda = (float*)(ws + WS_TDA); float* tmla = (float*)(ws + WS_TMLA); (void)tda; (void)tmla; \
    bf16_t* Wi = (bf16_t*)(ws + WS_WI); bf16_t* Wg = (bf16_t*)(ws + WS_WG); bf16_t* Wqb = (bf16_t*)(ws + WS_WQB); bf16_t* Wkvb = (bf16_t*)(ws + WS_WKVB); bf16_t* Wbda = (bf16_t*)(ws + WS_WBDA); \
    bf16_t* Wbmla = (bf16_t*)(ws + WS_WBMLA); bf16_t* Wout = (bf16_t*)(ws + WS_WOUT); bf16_t* Wgu = (bf16_t*)(ws + WS_WGU); bf16_t* Wd = (bf16_t*)(ws + WS_WD); \
    bf16_t* QKV = (bf16_t*)(ws + WS_QKV); bf16_t* TMP = QKV; bf16_t* X1B = QKV; bf16_t* CQKV = (bf16_t*)(ws + WS_CQKV); bf16_t* OM = CQKV; bf16_t* KR = (bf16_t*)(ws + WS_KR); \
    bf16_t* XN = (bf16_t*)(ws + WS_XN); bf16_t* KVM = (bf16_t*)(ws + WS_KVM); bf16_t* MRG = KVM; bf16_t* QM = (bf16_t*)(ws + WS_QM); bf16_t* ACT = (bf16_t*)(ws + WS_ACT); \
    (void)Wi; (void)Wg; (void)Wqb; (void)Wkvb; (void)Wbda; (void)Wbmla; (void)Wout; (void)Wgu; (void)Wd; (void)QKV; (void)TMP; (void)X1B; (void)CQKV; (void)OM; (void)KR; (void)XN; (void)KVM; (void)MRG; (void)QM; (void)ACT;
#define GRID_BAR() xcd_barrier((unsigned*)(a.ws + WS_BAR), bst, wv == 0 && lane_id() == 0)

    {
        PHASE_PTRS();
        LAS float* scr = (LAS float*)(lds + wave * 16384);
        if (bx == 0) for (int i = tid; i < XCD_BAR_WORDS; i += 512) ((unsigned*)(ws + WS_BAR))[i] = 0u;
        for (int i = bx * 512 + tid; i < S1 * 40; i += G * 512) {
            const int pos = i / 40, k = i % 40;
            const float expo = k < 8 ? (float)k * (1.0f / 8.0f) : (float)(k - 8) * (1.0f / 32.0f);
            const float inv = __builtin_amdgcn_exp2f(-expo * 18.931568569324174f);
            const float ang = (float)pos * inv;
            const double rev = (double)ang * 0.15915494309189535; const float fr = (float)(rev - __builtin_rint(rev));
            const float c = __builtin_amdgcn_cosf(fr), sn = __builtin_amdgcn_sinf(fr);
            if (k < 8) { tda[(size_t)pos * 16 + k] = c; tda[(size_t)pos * 16 + 8 + k] = sn; }
            else { tmla[(size_t)pos * 64 + (k - 8)] = c; tmla[(size_t)pos * 64 + 32 + (k - 8)] = sn; }
        }
        transpose_items(MapIn{a.in[3]}, 2048, NINP, Wi, nullptr, scr, gw, ngw, lane);
        transpose_items(MapG{a.in[3]}, 2048, 4096, Wg, nullptr, scr, gw, ngw, lane);
        transpose_items(MapQb{a.in[10]}, 512, 1536, Wqb, a.in[9], scr, gw, ngw, lane);
        transpose_items(MapId{a.in[12], 2048}, 512, 2048, Wkvb, a.in[11], scr, gw, ngw, lane);
        transpose_items(MapId{a.in[13], 2048}, 1024, 2048, Wbda, nullptr, scr, gw, ngw, lane);
        transpose_items(MapId{a.in[14], 2048}, 1024, 2048, Wbmla, nullptr, scr, gw, ngw, lane);
        const float* gn = a.in[2];
        for (int m = gw; m < T; m += ngw) {
            const float* xr = m < S0 ? x0 + (size_t)m * DM : x1 + (size_t)(m - S0) * DM;
            f32x4 v[8]; float sq = 0.f;
#pragma unroll
            for (int j = 0; j < 8; ++j) { v[j] = *(const f32x4*)(xr + j * 256 + lane * 4); sq += sumsq4(v[j]); }
            const float rs = rsqrtf(wave_sum(sq) * (1.0f / DM) + EPS);
#pragma unroll
            for (int j = 0; j < 8; ++j) { const f32x4 gv = *(const f32x4*)(gn + j * 256 + lane * 4); const f32x4 y = v[j] * rs * gv;
                u32x2 w; w.x = cvt_pk_bf16(y[0], y[1]); w.y = cvt_pk_bf16(y[2], y[3]); *(u32x2*)(XN + (size_t)m * DM + j * 256 + lane * 4) = w; }
        }
    }
    grid.sync();
    if (wv == 0 && lane_id() == 0) (void)xb_add(&((unsigned*)(a.ws + WS_BAR))[XB_XCNT(xb_xcc_id())], 1u);
    {
        PHASE_PTRS();
        pg8::Gemm g{XN, Wi, T, NINP, 2048, 2048}; pg8::StaticOrder S; S.init(T, NINP, G, bx);
        EpiIn E{QKV, CQKV, KR, ssq_q, ssq_kv, tda, tmla};
        pg8::gemm_phase(lds, g, S, E, wv);
    }
    GRID_BAR();
    {
        PHASE_PTRS();
        pg8::Gemm g{CQKV, Wqb, T, 1536, 512, 1024}; pg8::StaticOrder S; S.init(T, 1536, G, bx);
        EpiQb E{QM, ssq_q, tmla};
        pg8::gemm_phase(lds, g, S, E, wv);
    }
    {
        PHASE_PTRS();
        pg8::Gemm g{CQKV + 512, Wkvb, T, 2048, 512, 1024}; pg8::StaticOrder S; S.init(T, 2048, G, bx);
        EpiScale E{KVM, 2048, ssq_kv, 1.0f / 512.0f};
        pg8::gemm_phase(lds, g, S, E, wv);
    }
    GRID_BAR();
    {
        PHASE_PTRS();
        float lam;
        { const float a1 = a.in[4][lane] * a.in[5][lane], a2 = a.in[6][lane] * a.in[7][lane];
          lam = __builtin_amdgcn_exp2f(wave_sum(a1) * LOG2E) - __builtin_amdgcn_exp2f(wave_sum(a2) * LOG2E) + 0.2f; }
        const float* subg = a.in[8];
#ifdef PROBE_DA2
        for (int u = vcu; u < 1024 + 512; u += G) {
            const bool smp = u < 1024; const int uu = smp ? u : u - 1024;
            const int h = (uu & 255) >> 5, qb = (uu >> 8) * 32 + (uu & 31);
            const int seq0 = smp ? S0 : 0, seq = smp ? S1 : S0;
            const bf16_t* base = QKV + (size_t)seq0 * 3072 + h * 128;
            bf16_t* qp = QKV + (size_t)(seq0 + qb * 128) * 3072 + h * 128;
            att::attn_unit<0, false>(lds, qp, base + 1024, nullptr, base + 2048, seq, qp, lam, subg, wv);
        }
#endif
        for (int u = vcu; u < 1024 + 512; u += G) {
            const bool smp = u < 1024; const int uu = smp ? u : u - 1024;
            const int h = (uu & 255) >> 5, qb = (uu >> 8) * 32 + (uu & 31);
            const int seq0 = smp ? S0 : 0, seq = smp ? S1 : S0;
            const bf16_t* base = QKV + (size_t)seq0 * 3072 + h * 128;
            bf16_t* qp = QKV + (size_t)(seq0 + qb * 128) * 3072 + h * 128;
            att::attn_unit<0>(lds, qp, base + 1024, nullptr, base + 2048, seq, qp, lam, subg, wv);
        }
#ifdef PROBE_MLA2
        for (int rep_ = 0; rep_ < 2; ++rep_)
#endif
        for (int u = vcu; u < 512 + 256; u += G) {
            const bool smp = u < 512; const int uu = smp ? u : u - 512;
            const int h = (uu & 255) >> 5, qb = (uu >> 8) * 32 + (uu & 31);
            const int seq0 = smp ? S0 : 0, seq = smp ? S1 : S0;
            const bf16_t* qp = QM + (size_t)(seq0 + qb * 256) * 1536 + h * 192;
            const bf16_t* kp = KVM + (size_t)seq0 * 2048 + h * 256;
            att::attn_unit<1>(lds, qp, kp, KR + (size_t)seq0 * 64, kp + 128, seq, OM + (size_t)(seq0 + qb * 256) * 1024 + h * 128, 0.f, nullptr, wv);
        }
    }
    GRID_BAR();
    {
        PHASE_PTRS();
        LAS float* scr = (LAS float*)(lds + wave * 16384);
        transpose_items(MapId{a.in[15], 2048}, 2048, 2048, Wout, nullptr, scr, gw, ngw, lane);
        __syncthreads();
    }
    {
        PHASE_PTRS();
        pg8::Gemm g{QKV, Wbda, T, 2048, 1024, 3072}; pg8::StaticOrder S; S.init(T, 2048, G, bx);
        EpiPlain E{MRG, 2048};
        pg8::gemm_phase(lds, g, S, E, wv);
    }
    {
        PHASE_PTRS();
        pg8::Gemm g{XN, Wg, T, 2048, 2048, 2048}; pg8::StaticOrder S; S.init(T, 2048, G, bx);
        EpiGate<0> E{MRG, nullptr};
        pg8::gemm_phase(lds, g, S, E, wv);
    }
    GRID_BAR();
    {
        PHASE_PTRS();
        pg8::Gemm g{OM, Wbmla, T, 2048, 1024, 1024}; pg8::StaticOrder S; S.init(T, 2048, G, bx);
        EpiPlain E{TMP, 2048};
        pg8::gemm_phase(lds, g, S, E, wv);
    }
    {
        PHASE_PTRS();
        pg8::Gemm g{XN, Wg + (size_t)2048 * 2048, T, 2048, 2048, 2048}; pg8::StaticOrder S; S.init(T, 2048, G, bx);
        EpiGate<1> E{MRG, TMP};
        pg8::gemm_phase(lds, g, S, E, wv);
    }
    GRID_BAR();
    {
        PHASE_PTRS();
        pg8::Gemm g{MRG, Wout, T, 2048, 2048, 2048}; pg8::StaticOrder S; S.init(T, 2048, G, bx);
        EpiX1 E{x0, x1, X1B};
        pg8::gemm_phase(lds, g, S, E, wv);
    }
    GRID_BAR();
    {
        PHASE_PTRS();
        LAS float* scr = (LAS float*)(lds + wave * 16384);
        transpose_items(MapGu{a.in[17], a.in[18]}, 2048, 11264, Wgu, a.in[16], scr, gw, ngw, lane);
        transpose_items(MapId{a.in[19], 2048}, FF, 2048, Wd, nullptr, scr, gw, ngw, lane);
        for (int m = gw; m < T; m += ngw) {
            float sq = 0.f;
#pragma unroll
            for (int j = 0; j < 4; ++j) { f32x4 p, q; unpack8(*(const u32x4*)(X1B + (size_t)m * DM + j * 512 + lane * 8), p, q); sq += sumsq4(p) + sumsq4(q); }
            sq = wave_sum(sq);
            if (lane == 0) rstd1[m] = rsqrtf(sq * (1.0f / DM) + EPS);
        }
        __syncthreads();
    }
    GRID_BAR();
    {
        PHASE_PTRS();
        pg8::Gemm g{X1B, Wgu, T, 11264, 2048, 2048}; pg8::StaticOrder S; S.init(T, 11264, G, bx);
        EpiSwiGLU E{ACT, rstd1};
        pg8::gemm_phase(lds, g, S, E, wv);
    }
    GRID_BAR();
    {
        PHASE_PTRS();
        pg8::Gemm g{ACT, Wd, T, 2048, FF, FF}; pg8::StaticOrder S; S.init(T, 2048, G, bx);
        EpiX2 E{X1B};
        pg8::gemm_phase(lds, g, S, E, wv);
    }
    GRID_BAR();
    {
        PHASE_PTRS();
        const float* gn = a.in[20];
        for (int m = gw; m < T; m += ngw) {
            f32x4 v[8]; float sq = 0.f;
#pragma unroll
            for (int j = 0; j < 4; ++j) { unpack8(*(const u32x4*)(X1B + (size_t)m * DM + j * 512 + lane * 8), v[2 * j], v[2 * j + 1]); sq += sumsq4(v[2 * j]) + sumsq4(v[2 * j + 1]); }
            const float rs = rsqrtf(wave_sum(sq) * (1.0f / DM) + EPS);
            float* orow = a.out + (size_t)m * DM;
#pragma unroll
            for (int j = 0; j < 4; ++j) { const int c = j * 512 + lane * 8;
                *(f32x4*)(orow + c) = v[2 * j] * rs * *(const f32x4*)(gn + c); *(f32x4*)(orow + c + 4) = v[2 * j + 1] * rs * *(const f32x4*)(gn + c + 4); }
        }
    }
}

extern "C" void kernel_launch(void* const* d_in, const int* in_sizes, int n_in, void* d_out, int out_size, void* d_ws, size_t ws_size, hipStream_t stream) {
    static int grid = 0;
    if (grid == 0) {
        if (n_in != 21 || in_sizes[0] != S0 * DM || in_sizes[1] != S1 * DM || out_size != T * DM || ws_size < WS_END) {
            fprintf(stderr, "kernel_launch: shape mismatch n_in %d in0 %d in1 %d out %d ws %zu (need %zu)\n", n_in, n_in > 0 ? in_sizes[0] : -1, n_in > 1 ? in_sizes[1] : -1, out_size, ws_size, (size_t)WS_END);
            grid = -1; return; }
        int dev = 0, cus = 0, per_cu = 0;
        if (hipGetDevice(&dev) != hipSuccess || hipDeviceGetAttribute(&cus, hipDeviceAttributeMultiprocessorCount, dev) != hipSuccess) { grid = -1; return; }
        if (hipFuncSetAttribute((const void*)fwd_mega, hipFuncAttributeMaxDynamicSharedMemorySize, LDS_BYTES) != hipSuccess) { fprintf(stderr, "kernel_launch: hipFuncSetAttribute failed\n"); grid = -1; return; }
        if (hipOccupancyMaxActiveBlocksPerMultiprocessor(&per_cu, (const void*)fwd_mega, NWAVES * 64, LDS_BYTES) != hipSuccess || per_cu < 1) { fprintf(stderr, "kernel_launch: occupancy query says %d\n", per_cu); per_cu = 1; }
        (void)hipGetLastError();
        grid = cus * per_cu;
    }
    if (grid < 0) return;
    Args a{};
    for (int i = 0; i < 21; ++i) a.in[i] = (const float*)d_in[i];
    a.out = (float*)d_out; a.ws = (unsigned char*)d_ws;
    void* args[] = {&a};
    const hipError_t e = hipLaunchCooperativeKernel((void*)fwd_mega, dim3(grid), dim3(NWAVES * 64), args, LDS_BYTES, stream);
    if (e != hipSuccess) fprintf(stderr, "kernel_launch: cooperative launch failed: %s (grid %d)\n", hipGetErrorString(e), grid);
}
```

```cpp
#include <hip/hip_runtime.h>
#include <hip/hip_cooperative_groups.h>
#include <cstdio>
#include <cstdint>
namespace cg = cooperative_groups;

#define LAS __attribute__((address_space(3)))
typedef unsigned short bf16_t;
typedef short bf16x8 __attribute__((ext_vector_type(8)));
typedef short s16x4 __attribute__((ext_vector_type(4)));
typedef float f32x4 __attribute__((ext_vector_type(4)));
typedef float f32x16 __attribute__((ext_vector_type(16)));
typedef unsigned u32x4 __attribute__((ext_vector_type(4)));
typedef unsigned u32x2 __attribute__((ext_vector_type(2)));

constexpr int DM = 2048, S0 = 8192, S1 = 16384, T = S0 + S1;
constexpr int FF = 5632;
constexpr float EPS = 1e-6f;
constexpr float LOG2E = 1.4426950408889634f;

constexpr size_t MiB = 1u << 20;
constexpr size_t WS_SSQ = 0;
constexpr size_t WS_BAR = 2 * MiB;
constexpr size_t WS_RSTD = 2 * MiB + 256 * 1024;
constexpr size_t WS_TDA = 3 * MiB;
constexpr size_t WS_TMLA = 4 * MiB;
constexpr size_t WS_WI = 8 * MiB;
constexpr size_t WS_WG = 25 * MiB;
constexpr size_t WS_WQB = 41 * MiB;
constexpr size_t WS_WKVB = WS_WQB + 3 * MiB / 2;
constexpr size_t WS_WBDA = WS_WKVB + 2 * MiB;
constexpr size_t WS_WBMLA = WS_WBDA + 4 * MiB;
constexpr size_t WS_QKV = 53 * MiB;
constexpr size_t WS_CQKV = 197 * MiB;
constexpr size_t WS_KR = 245 * MiB;
constexpr size_t WS_XN = 248 * MiB;
constexpr size_t WS_KVM = 344 * MiB;
constexpr size_t WS_QM = 440 * MiB;
constexpr size_t WS_WOUT = 440 * MiB;
constexpr size_t WS_ACT = 149 * MiB;
constexpr size_t WS_WGU = 413 * MiB;
constexpr size_t WS_WD = 457 * MiB;
constexpr size_t WS_END = 512 * MiB;
constexpr int NINP = 4352;

__device__ __forceinline__ unsigned cvt_pk_bf16(float lo, float hi) { unsigned r; asm volatile("v_cvt_pk_bf16_f32 %0, %1, %2" : "=v"(r) : "v"(lo), "v"(hi)); return r; }
__device__ __forceinline__ float bf_lo(unsigned u) { return __uint_as_float(u << 16); }
__device__ __forceinline__ float bf_hi(unsigned u) { return __uint_as_float(u & 0xffff0000u); }
template <int K> __device__ __forceinline__ float shx(float v) {
    return __int_as_float(__builtin_amdgcn_ds_swizzle(__float_as_int(v), (K << 10) | 0x1f));
}
__device__ __forceinline__ float add_halves(float v) { auto rr = __builtin_amdgcn_permlane32_swap(__float_as_uint(v), __float_as_uint(v), false, false); return __uint_as_float(rr[0]) + __uint_as_float(rr[1]); }
__device__ __forceinline__ float wave_sum(float v) {
    v += shx<1>(v); v += shx<2>(v); v += shx<4>(v); v += shx<8>(v); v += shx<16>(v);
    return add_halves(v);
}
__device__ __forceinline__ float sigmoidf_(float x) { return __builtin_amdgcn_rcpf(1.0f + __builtin_amdgcn_exp2f(-x * LOG2E)); }
__device__ __forceinline__ void atomic_addf(float* p, float v) { __hip_atomic_fetch_add(p, v, __ATOMIC_RELAXED, __HIP_MEMORY_SCOPE_AGENT); }

__device__ __forceinline__ int lane_id() { return (int)__builtin_amdgcn_mbcnt_hi(~0u, __builtin_amdgcn_mbcnt_lo(~0u, 0u)); }
#define XB_TMO      128
#define XB_XCNT(j)  (256  + 64 * (j))
#define XB_XSUB(j)  (1280 + 64 * (j))
#define XB_XGEN(j)  (2304 + 64 * (j))
#define XB_TOP      3328
#define XB_TOPGEN   3392
#define XCD_BAR_WORDS 3456
#define XB_SPIN_CAP (1u << 22)
__device__ __forceinline__ unsigned xb_ld(unsigned* p)              { return __hip_atomic_load(p, __ATOMIC_RELAXED, __HIP_MEMORY_SCOPE_AGENT); }
__device__ __forceinline__ unsigned xb_add(unsigned* p, unsigned v) { return __hip_atomic_fetch_add(p, v, __ATOMIC_RELAXED, __HIP_MEMORY_SCOPE_AGENT); }
__device__ __forceinline__ unsigned xb_xcc_id() { return (unsigned)__builtin_amdgcn_s_getreg((3 << 11) | 20) & 0xFu; }
#define XB_SPIN(cond, bar) do { unsigned _sp = 0; while (cond) { __builtin_amdgcn_s_sleep(1); \
    if ((++_sp & 255u) == 0u) { if (xb_ld(&(bar)[XB_TMO])) break; if (_sp > XB_SPIN_CAP) { atomicAdd(&(bar)[XB_TMO], 1u); break; } } } } while (0)
__device__ __forceinline__ void xcd_barrier_complete(unsigned* bar, unsigned x, unsigned G, unsigned& nloc, unsigned& nx) {
    unsigned sum, cnt, mine, sp = 0u;
    for (;;) {
        sum = 0u; cnt = 0u; mine = 0u;
#pragma unroll
        for (unsigned j = 0; j < 16; ++j) { const unsigned c = xb_ld(&bar[XB_XCNT(j)]); sum += c; cnt += (c > 0u) ? 1u : 0u; mine = (j == x) ? c : mine; }
        if (sum == G) break;
        __builtin_amdgcn_s_sleep(1);
        if ((++sp & 255u) == 0u) { if (xb_ld(&bar[XB_TMO])) break; if (sp > XB_SPIN_CAP) { atomicAdd(&bar[XB_TMO], 1u); break; } }
    }
    nloc = mine > 0u ? mine : 1u; nx = cnt > 0u ? cnt : 1u;
}
__device__ __forceinline__ void xcd_barrier(unsigned* bar, volatile LAS unsigned* st, bool leader) {
    asm volatile("s_waitcnt vmcnt(0)" ::: "memory");
    __syncthreads();
    if (leader) {
        __builtin_amdgcn_s_waitcnt(0);
        const unsigned x = xb_xcc_id();
        unsigned nloc = st[0], nx = st[1];
        if (nloc == 0u) { xcd_barrier_complete(bar, x, gridDim.x, nloc, nx); st[0] = nloc; st[1] = nx; }
        const unsigned old = xb_add(&bar[XB_XSUB(x)], 1u);
        const unsigned gen = old / nloc;
        if (old + 1u == (gen + 1u) * nloc) {
            __builtin_amdgcn_fence(__ATOMIC_RELEASE, "agent");
            asm volatile("s_waitcnt vmcnt(0)" ::: "memory");
            const unsigned og = xb_add(&bar[XB_TOP], 1u);
            const unsigned tg = og / nx;
            if (og + 1u == (tg + 1u) * nx) xb_add(&bar[XB_TOPGEN], 1u);
            else XB_SPIN(xb_ld(&bar[XB_TOPGEN]) == tg, bar);
            __builtin_amdgcn_fence(__ATOMIC_ACQUIRE, "agent");
            xb_add(&bar[XB_XGEN(x)], 1u);
            asm volatile("s_waitcnt vmcnt(0)" ::: "memory");
        } else {
            XB_SPIN(xb_ld(&bar[XB_XGEN(x)]) == gen, bar);
            __builtin_amdgcn_fence(__ATOMIC_ACQUIRE, "agent");
            asm volatile("s_waitcnt vmcnt(0)" ::: "memory");
        }
    }
    __syncthreads();
}

namespace pg8 {
constexpr int BM = 256, BK = 64, HALF = 128, HTB = HALF * BK * 2, STAGE_BYTES = 8 * HTB, NXCD = 8, WGM = 8;
__host__ __device__ __forceinline__ int lds_byte(int r, int c) { const int st = (r >> 4) * 2 + (c >> 5), rr = r & 15, cc = c & 31, ob = rr * 64 + cc * 2; return st * 1024 + (ob ^ (((ob >> 9) & 1) << 5)); }
__host__ __device__ __forceinline__ void stage_rc(int b, int& R, int& C) { const int st = b / 1024, sb = b % 1024, swz = sb ^ (((sb >> 9) & 1) << 5); R = (st >> 1) * 16 + swz / 64; C = (st & 1) * 32 + (swz % 64) / 2; }
__host__ __device__ __forceinline__ int perm32(int rho) { const int n = rho >> 4, i = rho & 15; return 8 * (i >> 2) + 4 * n + (i & 3); }

struct Unit { int pm, pn; };
struct Gemm { const bf16_t* A; const bf16_t* Bt; int M, N, K, lda; };
struct StaticOrder {
    int nM, nN, nwg, G, c;
    __device__ void init(int M, int N, int G_, int c_) { nM = M / BM; nN = N / BM; nwg = nM * nN; G = G_; c = c_; }
    __device__ bool next(int i, Unit& u) const {
        const long L = (long)i * G + c; if (L >= nwg) return false;
        int wgid = (int)L; { const int q = nwg / NXCD, r = nwg % NXCD, xcd = wgid % NXCD, off = wgid / NXCD; wgid = (xcd < r ? xcd * (q + 1) : r * (q + 1) + (xcd - r) * q) + off; }
        const int nig = WGM * nN, gid = wgid / nig, fm = gid * WGM, gsz = (nM - fm) < WGM ? (nM - fm) : WGM;
        u.pm = fm + ((wgid % nig) % gsz); u.pn = (wgid % nig) / gsz; return true;
    }
};

template <class Epi, class Sched>
__device__ __forceinline__ void gemm_phase(LAS unsigned char* lds, const Gemm g, const Sched& S, const Epi& E, int wv) {
    int tid = wv * 64 + lane_id(); asm volatile("" : "+v"(tid));
    const int wid = __builtin_amdgcn_readfirstlane(tid >> 6), lane = tid & 63, wr = wid >> 2, wc = wid & 3, fr = lane & 15, fq = lane >> 4;
    const int K = g.K, nt = K / BK, lda = g.lda;
    unsigned voffA[2], voffB[2];
#pragma unroll
    for (int i = 0; i < 2; ++i) { int R, C; stage_rc(tid * 16 + i * 8192, R, C); const int Rb = Epi::PERM ? ((R & ~31) + perm32(R & 31)) : R;
        voffA[i] = (unsigned)(R * lda + C) * 2u; voffB[i] = (unsigned)(Rb * K + C) * 2u; }
    const size_t kstep = (size_t)(BK * 2);
    const size_t hstepA = (size_t)HALF * lda * 2, hstepB = (size_t)HALF * K * 2;
    const size_t tstepA = 2 * hstepA, tstepB = 2 * hstepB;
    const unsigned ldsw = (unsigned)wid * 1024u;
    const int aoff = lds_byte(wr * 64 + fr, fq * 8), boff = lds_byte(wc * 32 + fr, fq * 8);
#define PG8_SA(b, h) (((b) * 2 + (h)) * HTB)
#define PG8_SB(b, h) ((4 + (b) * 2 + (h)) * HTB)
#define PG8_STAGE(bufoff, gbase, voff) do { _Pragma("unroll") for (int _i = 0; _i < 2; ++_i) \
        __builtin_amdgcn_global_load_lds((const unsigned*)((const char*)(gbase) + (voff)[_i]), (LAS unsigned*)(lds + (bufoff) + ldsw + _i * 8192), 16, 0, 0); } while (0)
#define PG8_LDA(dst, b, h) do { _Pragma("unroll") for (int m = 0; m < 4; ++m) _Pragma("unroll") for (int k = 0; k < 2; ++k) dst[m][k] = *(const LAS bf16x8*)(lds + PG8_SA(b, h) + aoff + m * 2048 + k * 1024); } while (0)
#define PG8_LDB(dst, b, h) do { _Pragma("unroll") for (int n = 0; n < 2; ++n) _Pragma("unroll") for (int k = 0; k < 2; ++k) dst[n][k] = *(const LAS bf16x8*)(lds + PG8_SB(b, h) + boff + n * 2048 + k * 1024); } while (0)
#define PG8_MMA(ai, bj, At, Bt) do { __builtin_amdgcn_s_setprio(1); _Pragma("unroll") for (int m = 0; m < 4; ++m) _Pragma("unroll") for (int n = 0; n < 2; ++n) _Pragma("unroll") for (int k = 0; k < 2; ++k) \
        acc[ai][bj][m][n] = __builtin_amdgcn_mfma_f32_16x16x32_bf16(Bt[n][k], At[m][k], acc[ai][bj][m][n], 0, 0, 0); __builtin_amdgcn_s_setprio(0); } while (0)
#define PG8_WAIT_V(n) asm volatile("s_waitcnt vmcnt(" #n ")" ::: "memory")
#define PG8_WAIT_L(n) asm volatile("s_waitcnt lgkmcnt(" #n ")" ::: "memory")
#define PG8_BAR __builtin_amdgcn_s_barrier()
#define PG8_SCHED __builtin_amdgcn_sched_barrier(0)
    Unit cur, nxt; int ui = 0;
    if (!S.next(0, cur)) return;
    f32x4 acc[2][2][4][2];
#pragma unroll
    for (int a = 0; a < 2; ++a)
#pragma unroll
        for (int b = 0; b < 2; ++b)
#pragma unroll
            for (int m = 0; m < 4; ++m)
#pragma unroll
                for (int n = 0; n < 2; ++n) acc[a][b][m][n] = (f32x4){0.f, 0.f, 0.f, 0.f};
    bf16x8 At[4][2], B0[2][2], B1[2][2];
    const char* cA = (const char*)g.A + (size_t)cur.pm * tstepA; const char* cB = (const char*)g.Bt + (size_t)cur.pn * tstepB;
    PG8_STAGE(PG8_SB(0, 0), cB, voffB); PG8_STAGE(PG8_SB(0, 1), cB + hstepB, voffB); PG8_STAGE(PG8_SA(0, 0), cA, voffA); PG8_STAGE(PG8_SA(0, 1), cA + hstepA, voffA);
    if (wr == 1) PG8_BAR;
    PG8_WAIT_V(2); PG8_BAR;
    PG8_STAGE(PG8_SB(1, 0), cB + kstep, voffB); PG8_STAGE(PG8_SA(1, 0), cA + kstep, voffA); PG8_STAGE(PG8_SB(1, 1), cB + hstepB + kstep, voffB);
    PG8_WAIT_V(6); PG8_BAR;
    for (;;) {
        const bool has_next = S.next(ui + 1, nxt);
        const char* nA = has_next ? (const char*)g.A + (size_t)nxt.pm * tstepA : cA; const char* nB = has_next ? (const char*)g.Bt + (size_t)nxt.pn * tstepB : cB;
        for (int t = 0; t < nt; t += 2) {
            const bool last = (t == nt - 2);
            const char* a1 = cA + (size_t)(t + 1) * kstep;
            const char* a2 = last ? nA : cA + (size_t)(t + 2) * kstep; const char* b2 = last ? nB : cB + (size_t)(t + 2) * kstep;
            const char* a3 = a2 + kstep; const char* b3 = b2 + kstep;
            PG8_LDB(B0, 0, 0); PG8_LDB(B1, 0, 1); PG8_SCHED; PG8_LDA(At, 0, 0); PG8_STAGE(PG8_SA(1, 1), a1 + hstepA, voffA);
            PG8_WAIT_V(8); PG8_WAIT_L(0); PG8_BAR; PG8_MMA(0, 0, At, B0); PG8_MMA(0, 1, At, B1); PG8_BAR; PG8_SCHED;
            PG8_LDA(At, 0, 1); PG8_STAGE(PG8_SB(0, 0), b2, voffB); PG8_STAGE(PG8_SB(0, 1), b2 + hstepB, voffB); PG8_STAGE(PG8_SA(0, 0), a2, voffA);
            PG8_WAIT_V(8); PG8_WAIT_L(0); PG8_BAR; PG8_MMA(1, 0, At, B0); PG8_MMA(1, 1, At, B1); PG8_BAR; PG8_SCHED;
            PG8_LDB(B0, 1, 0); PG8_LDB(B1, 1, 1); PG8_SCHED; PG8_LDA(At, 1, 0); PG8_STAGE(PG8_SA(0, 1), a2 + hstepA, voffA);
            PG8_WAIT_V(8); PG8_WAIT_L(0); PG8_BAR; PG8_MMA(0, 0, At, B0); PG8_MMA(0, 1, At, B1); PG8_BAR; PG8_SCHED;
            PG8_LDA(At, 1, 1); PG8_STAGE(PG8_SB(1, 0), b3, voffB); PG8_STAGE(PG8_SB(1, 1), b3 + hstepB, voffB); PG8_STAGE(PG8_SA(1, 0), a3, voffA);
            PG8_WAIT_V(8); PG8_WAIT_L(0); PG8_BAR; PG8_MMA(1, 0, At, B0); PG8_MMA(1, 1, At, B1); PG8_BAR; PG8_SCHED;
        }
        if (wr == 0) PG8_BAR;
        E(acc, cur, wr, wc, fr, fq);
        if (!has_next) break;
#pragma unroll
        for (int a = 0; a < 2; ++a)
#pragma unroll
            for (int b = 0; b < 2; ++b)
#pragma unroll
                for (int m = 0; m < 4; ++m)
#pragma unroll
                    for (int n = 0; n < 2; ++n) acc[a][b][m][n] = (f32x4){0.f, 0.f, 0.f, 0.f};
        cur = nxt; cA = nA; cB = nB; ++ui;
        if (wr == 1) PG8_BAR;
    }
    PG8_WAIT_V(0);
    PG8_BAR;
#undef PG8_SA
#undef PG8_SB
#undef PG8_STAGE
#undef PG8_LDA
#undef PG8_LDB
#undef PG8_MMA
#undef PG8_WAIT_V
#undef PG8_WAIT_L
#undef PG8_BAR
#undef PG8_SCHED
}
}

typedef const f32x4 (&AccRef)[2][2][4][2];
__device__ __forceinline__ u32x4 pack8(f32x4 v0, f32x4 v1) { u32x4 w; w.x = cvt_pk_bf16(v0[0], v0[1]); w.y = cvt_pk_bf16(v0[2], v0[3]); w.z = cvt_pk_bf16(v1[0], v1[1]); w.w = cvt_pk_bf16(v1[2], v1[3]); return w; }
__device__ __forceinline__ float sumsq4(f32x4 v) { return (v[0] * v[0] + v[1] * v[1]) + (v[2] * v[2] + v[3] * v[3]); }

struct EpiIn {
    static constexpr bool PERM = true;
    bf16_t* QKV; bf16_t* CQKV; bf16_t* KR; float* ssq_q; float* ssq_kv; const float* tda; const float* tmla;
    __device__ __forceinline__ void operator()(AccRef acc, const pg8::Unit& u, int wr, int wc, int fr, int fq) const {
        const int pn = u.pn, row0 = u.pm * 256 + wr * 64 + fr, cl = wc * 32 + 8 * fq;
        if (pn < 12) {
            const bool rope = (pn < 8) && ((wc & 1) == 0) && (fq < 2);
#pragma unroll
            for (int ai = 0; ai < 2; ++ai)
#pragma unroll
                for (int m = 0; m < 4; ++m) {
                    const int row = row0 + ai * 128 + m * 16; const int pos = row < S0 ? row : row - S0;
                    f32x4 cs = (f32x4){1.f, 1.f, 1.f, 1.f}, sn = (f32x4){0.f, 0.f, 0.f, 0.f};
                    if (rope) { cs = *(const f32x4*)(tda + (size_t)pos * 16 + 4 * fq); sn = *(const f32x4*)(tda + (size_t)pos * 16 + 8 + 4 * fq); }
#pragma unroll
                    for (int bj = 0; bj < 2; ++bj) {
                        const f32x4 v0 = acc[ai][bj][m][0], v1 = acc[ai][bj][m][1];
                        const f32x4 o0 = v0 * cs - v1 * sn, o1 = v1 * cs + v0 * sn;
                        const float qs = pn < 4 ? 0.125f * LOG2E : 1.0f;
                        *(u32x4*)(QKV + (size_t)row * 3072 + pn * 256 + bj * 128 + cl) = rope ? pack8(o0 * qs, o1 * qs) : pack8(v0 * qs, v1 * qs);
                    }
                }
        } else if (pn < 16) {
            float* ssq = pn < 14 ? ssq_q : ssq_kv;
#pragma unroll
            for (int ai = 0; ai < 2; ++ai)
#pragma unroll
                for (int m = 0; m < 4; ++m) {
                    const int row = row0 + ai * 128 + m * 16; float s = 0.f;
#pragma unroll
                    for (int bj = 0; bj < 2; ++bj) {
                        const f32x4 v0 = acc[ai][bj][m][0], v1 = acc[ai][bj][m][1];
                        s += sumsq4(v0) + sumsq4(v1);
                        *(u32x4*)(CQKV + (size_t)row * 1024 + (pn - 12) * 256 + bj * 128 + cl) = pack8(v0, v1);
                    }
                    s += shx<16>(s); s = add_halves(s);
                    if (fq == 0) ssq[(size_t)row * 8 + (pn & 1) * 4 + wc] = s;
                }
        } else {
            if (wc < 2) {
                const int g4 = 4 * (4 * wc + fq);
#pragma unroll
                for (int ai = 0; ai < 2; ++ai)
#pragma unroll
                    for (int m = 0; m < 4; ++m) {
                        const int row = row0 + ai * 128 + m * 16; const int pos = row < S0 ? row : row - S0;
                        const f32x4 cs = *(const f32x4*)(tmla + (size_t)pos * 64 + g4), sn = *(const f32x4*)(tmla + (size_t)pos * 64 + 32 + g4);
                        const f32x4 v0 = acc[ai][0][m][0], v1 = acc[ai][0][m][1];
                        const f32x4 o0 = v0 * cs - v1 * sn, o1 = v1 * cs + v0 * sn;
                        *(u32x4*)(KR + (size_t)row * 64 + cl) = pack8(o0, o1);
                    }
            }
        }
    }
};
struct EpiQb {
    static constexpr bool PERM = true;
    bf16_t* QM; const float* ssq_q; const float* tmla;
    __device__ __forceinline__ void operator()(AccRef acc, const pg8::Unit& u, int wr, int wc, int fr, int fq) const {
        const int pn = u.pn, row0 = u.pm * 256 + wr * 64 + fr, cl = wc * 32 + 8 * fq;
        const int g4 = 4 * (4 * (wc & 1) + fq);
        const bool rp0 = ((pn * 4 + 0 + (wc >> 1)) % 3) == 2, rp1 = ((pn * 4 + 2 + (wc >> 1)) % 3) == 2;
#pragma unroll
        for (int ai = 0; ai < 2; ++ai)
#pragma unroll
            for (int m = 0; m < 4; ++m) {
                const int row = row0 + ai * 128 + m * 16; const int pos = row < S0 ? row : row - S0;
                const f32x4 sa = *(const f32x4*)(ssq_q + (size_t)row * 8), sb = *(const f32x4*)(ssq_q + (size_t)row * 8 + 4);
                const float rs = rsqrtf((((sa[0] + sa[1]) + (sa[2] + sa[3])) + ((sb[0] + sb[1]) + (sb[2] + sb[3]))) * (1.0f / 512.0f) + EPS) * (0.07216878364870322f * LOG2E);
                f32x4 cs = (f32x4){1.f, 1.f, 1.f, 1.f}, sn = (f32x4){0.f, 0.f, 0.f, 0.f};
                if (rp0 || rp1) { cs = *(const f32x4*)(tmla + (size_t)pos * 64 + g4); sn = *(const f32x4*)(tmla + (size_t)pos * 64 + 32 + g4); }
#pragma unroll
                for (int bj = 0; bj < 2; ++bj) {
                    const bool rp = bj ? rp1 : rp0;
                    const f32x4 v0 = acc[ai][bj][m][0] * rs, v1 = acc[ai][bj][m][1] * rs;
                    const f32x4 o0 = v0 * cs - v1 * sn, o1 = v1 * cs + v0 * sn;
                    *(u32x4*)(QM + (size_t)row * 1536 + pn * 256 + bj * 128 + cl) = rp ? pack8(o0, o1) : pack8(v0, v1);
                }
            }
    }
};
struct EpiScale {
    static constexpr bool PERM = true;
    bf16_t* O; int ldo; const float* ssq; float inv_n;
    __device__ __forceinline__ void operator()(AccRef acc, const pg8::Unit& u, int wr, int wc, int fr, int fq) const {
        const int pn = u.pn, row0 = u.pm * 256 + wr * 64 + fr, cl = wc * 32 + 8 * fq;
#pragma unroll
        for (int ai = 0; ai < 2; ++ai)
#pragma unroll
            for (int m = 0; m < 4; ++m) {
                const int row = row0 + ai * 128 + m * 16;
                const f32x4 sa = *(const f32x4*)(ssq + (size_t)row * 8), sb = *(const f32x4*)(ssq + (size_t)row * 8 + 4);
                const float rs = rsqrtf((((sa[0] + sa[1]) + (sa[2] + sa[3])) + ((sb[0] + sb[1]) + (sb[2] + sb[3]))) * inv_n + EPS);
#pragma unroll
                for (int bj = 0; bj < 2; ++bj)
                    *(u32x4*)(O + (size_t)row * ldo + pn * 256 + bj * 128 + cl) = pack8(acc[ai][bj][m][0] * rs, acc[ai][bj][m][1] * rs);
            }
    }
};
__device__ __forceinline__ void unpack8(u32x4 w, f32x4& a, f32x4& b) { a = (f32x4){bf_lo(w.x), bf_hi(w.x), bf_lo(w.y), bf_hi(w.y)}; b = (f32x4){bf_lo(w.z), bf_hi(w.z), bf_lo(w.w), bf_hi(w.w)}; }
struct EpiPlain {
    static constexpr bool PERM = true;
    bf16_t* O; int ldo;
    __device__ __forceinline__ void operator()(AccRef acc, const pg8::Unit& u, int wr, int wc, int fr, int fq) const {
        const int pn = u.pn, row0 = u.pm * 256 + wr * 64 + fr, cl = wc * 32 + 8 * fq;
#pragma unroll
        for (int ai = 0; ai < 2; ++ai)
#pragma unroll
            for (int m = 0; m < 4; ++m) {
                const int row = row0 + ai * 128 + m * 16;
#pragma unroll
                for (int bj = 0; bj < 2; ++bj) *(u32x4*)(O + (size_t)row * ldo + pn * 256 + bj * 128 + cl) = pack8(acc[ai][bj][m][0], acc[ai][bj][m][1]);
            }
    }
};
template <int MODE> struct EpiGate {
    static constexpr bool PERM = true;
    bf16_t* MRG; const bf16_t* TMP;
    __device__ __forceinline__ void operator()(AccRef acc, const pg8::Unit& u, int wr, int wc, int fr, int fq) const {
        const int pn = u.pn, row0 = u.pm * 256 + wr * 64 + fr, cl = wc * 32 + 8 * fq;
#pragma unroll
        for (int ai = 0; ai < 2; ++ai)
#pragma unroll
            for (int m = 0; m < 4; ++m) {
                const int row = row0 + ai * 128 + m * 16;
#pragma unroll
                for (int bj = 0; bj < 2; ++bj) {
                    const size_t off = (size_t)row * 2048 + pn * 256 + bj * 128 + cl;
                    f32x4 g0 = acc[ai][bj][m][0], g1 = acc[ai][bj][m][1];
#pragma unroll
                    for (int e = 0; e < 4; ++e) { g0[e] = sigmoidf_(g0[e]); g1[e] = sigmoidf_(g1[e]); }
                    f32x4 m0, m1; unpack8(*(const u32x4*)(MRG + off), m0, m1);
                    if (MODE == 0) { m0 = m0 * g0; m1 = m1 * g1; }
                    else { f32x4 t0, t1; unpack8(*(const u32x4*)(TMP + off), t0, t1); m0 = m0 + g0 * t0; m1 = m1 + g1 * t1; }
                    *(u32x4*)(MRG + off) = pack8(m0, m1);
                }
            }
    }
};
struct EpiX1 {
    static constexpr bool PERM = true;
    const float* x0; const float* x1; bf16_t* XB;
    __device__ __forceinline__ void operator()(AccRef acc, const pg8::Unit& u, int wr, int wc, int fr, int fq) const {
        const int pn = u.pn, row0 = u.pm * 256 + wr * 64 + fr, cl = wc * 32 + 8 * fq;
#pragma unroll
        for (int ai = 0; ai < 2; ++ai)
#pragma unroll
            for (int m = 0; m < 4; ++m) {
                const int row = row0 + ai * 128 + m * 16;
                const float* xr = row < S0 ? x0 + (size_t)row * DM : x1 + (size_t)(row - S0) * DM;
#pragma unroll
                for (int bj = 0; bj < 2; ++bj) {
                    const int col = pn * 256 + bj * 128 + cl;
                    const f32x4 a0 = *(const f32x4*)(xr + col) + acc[ai][bj][m][0], a1 = *(const f32x4*)(xr + col + 4) + acc[ai][bj][m][1];
                    *(u32x4*)(XB + (size_t)row * DM + col) = pack8(a0, a1);
                }
            }
    }
};
struct EpiX2 {
    static constexpr bool PERM = true;
    bf16_t* XB;
    __device__ __forceinline__ void operator()(AccRef acc, const pg8::Unit& u, int wr, int wc, int fr, int fq) const {
        const int pn = u.pn, row0 = u.pm * 256 + wr * 64 + fr, cl = wc * 32 + 8 * fq;
#pragma unroll
        for (int ai = 0; ai < 2; ++ai)
#pragma unroll
            for (int m = 0; m < 4; ++m) {
                const int row = row0 + ai * 128 + m * 16;
#pragma unroll
                for (int bj = 0; bj < 2; ++bj) {
                    const size_t off = (size_t)row * DM + pn * 256 + bj * 128 + cl;
                    f32x4 m0, m1; unpack8(*(const u32x4*)(XB + off), m0, m1);
                    *(u32x4*)(XB + off) = pack8(m0 + acc[ai][bj][m][0], m1 + acc[ai][bj][m][1]);
                }
            }
    }
};
struct EpiSwiGLU {
    static constexpr bool PERM = true;
    bf16_t* ACT; const float* rstd;
    __device__ __forceinline__ void operator()(AccRef acc, const pg8::Unit& u, int wr, int wc, int fr, int fq) const {
        const int pn = u.pn, row0 = u.pm * 256 + wr * 64 + fr, cl = wc * 32 + 8 * fq;
#pragma unroll
        for (int ai = 0; ai < 2; ++ai)
#pragma unroll
            for (int m = 0; m < 4; ++m) {
                const int row = row0 + ai * 128 + m * 16;
                const float rs = rstd[row];
                f32x4 a[2];
#pragma unroll
                for (int n = 0; n < 2; ++n) { const f32x4 gt = acc[ai][0][m][n] * rs, up = acc[ai][1][m][n] * rs;
#pragma unroll
                    for (int e = 0; e < 4; ++e) a[n][e] = gt[e] * sigmoidf_(gt[e]) * up[e]; }
                *(u32x4*)(ACT + (size_t)row * FF + pn * 128 + cl) = pack8(a[0], a[1]);
            }
    }
};

namespace att {
constexpr int KVBLK = 64, SHM_V = 16384, SHM_K = 16384, SHM_KR = 8192;
#define KSWZ(row, colB) ((row) * 256 + ((colB) ^ (((row) & 15) << 4)))
#define KRSWZ(row, colB) ((row) * 128 + ((colB) ^ ((((row) >> 1) & 7) << 4)))
#define SBAR() __builtin_amdgcn_sched_barrier(0)
__device__ __forceinline__ int crow(int r, int hi) { return (r & 3) + 8 * (r >> 2) + 4 * hi; }
template <int MODE> struct Cst { static constexpr float SCALE = MODE ? 0.07216878364870322f : 0.125f; static constexpr float C = SCALE * LOG2E; static constexpr float THRS = 8.0f * LOG2E; };

template <int MODE> __device__ __forceinline__ void partialSM(f32x16& p0, f32x16& p1, float& m_reg, float& mn, float& alpha) {
    float pmax = p0[0];
#pragma unroll
    for (int r = 1; r < 16; ++r) pmax = fmaxf(pmax, p0[r]);
#pragma unroll
    for (int r = 0; r < 16; ++r) pmax = fmaxf(pmax, p1[r]);
    { auto rr = __builtin_amdgcn_permlane32_swap(__float_as_uint(pmax), __float_as_uint(pmax), false, false);
      pmax = fmaxf(__uint_as_float(rr[0]), __uint_as_float(rr[1])); }
    if (__builtin_expect(__all(pmax - m_reg <= Cst<MODE>::THRS), 1)) { mn = m_reg; alpha = 1.f; }
    else { mn = fmaxf(m_reg, pmax); alpha = __builtin_amdgcn_exp2f(m_reg - mn); m_reg = mn; }
#pragma unroll
    for (int r = 0; r < 16; ++r) p0[r] = p0[r] - mn;
#pragma unroll
    for (int r = 0; r < 16; ++r) p1[r] = p1[r] - mn;
#pragma unroll
    for (int r = 0; r < 16; ++r) p0[r] = __builtin_amdgcn_exp2f(p0[r]);
}
__device__ __forceinline__ void finishSM(f32x16& p0, f32x16& p1, float alpha, float& l_reg, bf16x8& pa0, bf16x8& pa1, bf16x8& pa2, bf16x8& pa3) {
#pragma unroll
    for (int r = 0; r < 16; ++r) p1[r] = __builtin_amdgcn_exp2f(p1[r]);
    typedef float f32x2 __attribute__((ext_vector_type(2)));
    f32x2 s2 = (f32x2){p0[0], p0[1]};
#pragma unroll
    for (int r = 2; r < 16; r += 2) s2 += (f32x2){p0[r], p0[r + 1]};
#pragma unroll
    for (int r = 0; r < 16; r += 2) s2 += (f32x2){p1[r], p1[r + 1]};
    float ps = s2.x + s2.y;
    { auto rr = __builtin_amdgcn_permlane32_swap(__float_as_uint(ps), __float_as_uint(ps), false, false);
      ps = __uint_as_float(rr[0]) + __uint_as_float(rr[1]); }
    l_reg = l_reg * alpha + ps;
#define PK4(P, BASE, OUT) do { unsigned a0 = cvt_pk_bf16(P[BASE + 0], P[BASE + 1]), a1 = cvt_pk_bf16(P[BASE + 2], P[BASE + 3]);   \
    unsigned b0 = cvt_pk_bf16(P[BASE + 4], P[BASE + 5]), b1 = cvt_pk_bf16(P[BASE + 6], P[BASE + 7]);                              \
    auto r0 = __builtin_amdgcn_permlane32_swap(a0, b0, false, false); auto r1 = __builtin_amdgcn_permlane32_swap(a1, b1, false, false); \
    u32x4 w = {r0[0], r1[0], r0[1], r1[1]}; OUT = *reinterpret_cast<bf16x8*>(&w); } while (0)
    PK4(p0, 0, pa0); PK4(p0, 8, pa1); PK4(p1, 0, pa2); PK4(p1, 8, pa3);
#undef PK4
}
template <int MODE> __device__ __forceinline__ void qkt(f32x16& p0, f32x16& p1, const LAS unsigned char* Kt, const LAS unsigned char* Krt, const bf16x8* qr, int r32, int hi, int comp) {
    p0 = f32x16{}; p1 = f32x16{};
    constexpr int NDN = MODE ? 8 : 4;
#pragma unroll
    for (int d0 = 0; d0 < NDN; ++d0) { const int cb = ((MODE ? 0 : comp * 64) + d0 * 16 + hi * 8) * 2;
        const bf16x8 b0 = *(const LAS bf16x8*)(Kt + KSWZ(r32, cb));
        const bf16x8 b1 = *(const LAS bf16x8*)(Kt + KSWZ(32 + r32, cb));
        p0 = __builtin_amdgcn_mfma_f32_32x32x16_bf16(b0, qr[d0], p0, 0, 0, 0);
        p1 = __builtin_amdgcn_mfma_f32_32x32x16_bf16(b1, qr[d0], p1, 0, 0, 0); }
    if constexpr (MODE == 1) {
#pragma unroll
        for (int d0 = 0; d0 < 4; ++d0) { const int cb = (d0 * 16 + hi * 8) * 2;
            const bf16x8 b0 = *(const LAS bf16x8*)(Krt + KRSWZ(r32, cb));
            const bf16x8 b1 = *(const LAS bf16x8*)(Krt + KRSWZ(32 + r32, cb));
            p0 = __builtin_amdgcn_mfma_f32_32x32x16_bf16(b0, qr[8 + d0], p0, 0, 0, 0);
            p1 = __builtin_amdgcn_mfma_f32_32x32x16_bf16(b1, qr[8 + d0], p1, 0, 0, 0); }
    }
}
__device__ __forceinline__ int v_st(int k, int c) { const int kk = (k & ~0xC) | ((k & 4) << 1) | ((k & 8) >> 1); return ((kk >> 3) * 4 + (c >> 5)) * 512 + ((kk & 7) * 32 + (c & 31)) * 2; }
__device__ __forceinline__ int v_rd_base(int lane) { return ((lane & 3) << 3) | (((lane >> 2) & 3) << 6) | (((lane >> 4) & 1) << 5) | (((lane >> 5) & 1) << 8); }
constexpr int v_rd_off(int d0, int ks, int half) { return d0 * 512 + ks * 4096 + half * 2048; }
template <int OFF> __device__ __forceinline__ s16x4 tr_read(int vb) {
    s16x4 r; asm volatile("ds_read_b64_tr_b16 %0, %1 offset:%2" : "=&v"(r) : "v"(vb), "i"(OFF) : "memory"); return r;
}
template <int D0> __device__ __forceinline__ void pv_one(f32x16& od, int vb, bf16x8 pa0, bf16x8 pa1, bf16x8 pa2, bf16x8 pa3) {
    const s16x4 l0 = tr_read<v_rd_off(D0, 0, 0)>(vb), h0 = tr_read<v_rd_off(D0, 0, 1)>(vb), l1 = tr_read<v_rd_off(D0, 1, 0)>(vb), h1 = tr_read<v_rd_off(D0, 1, 1)>(vb);
    const s16x4 l2 = tr_read<v_rd_off(D0, 2, 0)>(vb), h2 = tr_read<v_rd_off(D0, 2, 1)>(vb), l3 = tr_read<v_rd_off(D0, 3, 0)>(vb), h3 = tr_read<v_rd_off(D0, 3, 1)>(vb);
    asm volatile("s_waitcnt lgkmcnt(0)" ::: "memory"); SBAR();
#define PK(L, H) (bf16x8){L[0], L[1], L[2], L[3], H[0], H[1], H[2], H[3]}
    od = __builtin_amdgcn_mfma_f32_32x32x16_bf16(pa0, PK(l0, h0), od, 0, 0, 0);
    od = __builtin_amdgcn_mfma_f32_32x32x16_bf16(pa1, PK(l1, h1), od, 0, 0, 0);
    od = __builtin_amdgcn_mfma_f32_32x32x16_bf16(pa2, PK(l2, h2), od, 0, 0, 0);
    od = __builtin_amdgcn_mfma_f32_32x32x16_bf16(pa3, PK(l3, h3), od, 0, 0, 0);
#undef PK
}
__device__ __forceinline__ void pv_d0(f32x16* o, int vb, bf16x8 pa0, bf16x8 pa1, bf16x8 pa2, bf16x8 pa3) {
    pv_one<0>(o[0], vb, pa0, pa1, pa2, pa3); pv_one<1>(o[1], vb, pa0, pa1, pa2, pa3); pv_one<2>(o[2], vb, pa0, pa1, pa2, pa3); pv_one<3>(o[3], vb, pa0, pa1, pa2, pa3);
}
struct VFrag { s16x4 l0, h0, l1, h1, l2, h2, l3, h3; };
template <int D0> __device__ __forceinline__ void v_frag_read(VFrag& f, int vb) {
    f.l0 = tr_read<v_rd_off(D0, 0, 0)>(vb); f.h0 = tr_read<v_rd_off(D0, 0, 1)>(vb); f.l1 = tr_read<v_rd_off(D0, 1, 0)>(vb); f.h1 = tr_read<v_rd_off(D0, 1, 1)>(vb);
    f.l2 = tr_read<v_rd_off(D0, 2, 0)>(vb); f.h2 = tr_read<v_rd_off(D0, 2, 1)>(vb); f.l3 = tr_read<v_rd_off(D0, 3, 0)>(vb); f.h3 = tr_read<v_rd_off(D0, 3, 1)>(vb);
}
__device__ __forceinline__ void pv_mma(f32x16& od, const VFrag& f, bf16x8 pa0, bf16x8 pa1, bf16x8 pa2, bf16x8 pa3) {
#define PK(L, H) (bf16x8){L[0], L[1], L[2], L[3], H[0], H[1], H[2], H[3]}
    od = __builtin_amdgcn_mfma_f32_32x32x16_bf16(pa0, PK(f.l0, f.h0), od, 0, 0, 0);
    od = __builtin_amdgcn_mfma_f32_32x32x16_bf16(pa1, PK(f.l1, f.h1), od, 0, 0, 0);
    od = __builtin_amdgcn_mfma_f32_32x32x16_bf16(pa2, PK(f.l2, f.h2), od, 0, 0, 0);
    od = __builtin_amdgcn_mfma_f32_32x32x16_bf16(pa3, PK(f.l3, f.h3), od, 0, 0, 0);
#undef PK
}
#define LW(n) asm volatile("s_waitcnt lgkmcnt(" #n ")" ::: "memory")
template <int MODE, bool PF> __device__ __forceinline__ void pv_partial(f32x16* o, int vb, bf16x8 pa0, bf16x8 pa1, bf16x8 pa2, bf16x8 pa3, f32x16& p0, f32x16& p1, float& m_reg, float& alpha) {
    VFrag fa, fb;
    v_frag_read<0>(fa, vb);
    if constexpr (PF) { v_frag_read<1>(fb, vb); LW(8); } else LW(0);
    SBAR();
    pv_mma(o[0], fa, pa0, pa1, pa2, pa3);
    float pm0 = p0[0];
#pragma unroll
    for (int r = 1; r < 16; ++r) pm0 = fmaxf(pm0, p0[r]);
    if constexpr (PF) { v_frag_read<2>(fa, vb); LW(8); } else { v_frag_read<1>(fb, vb); LW(0); }
    SBAR();
    pv_mma(o[1], fb, pa0, pa1, pa2, pa3);
    float pmax = pm0;
#pragma unroll
    for (int r = 0; r < 16; ++r) pmax = fmaxf(pmax, p1[r]);
    { auto rr = __builtin_amdgcn_permlane32_swap(__float_as_uint(pmax), __float_as_uint(pmax), false, false);
      pmax = fmaxf(__uint_as_float(rr[0]), __uint_as_float(rr[1])); }
    const float mn = (pmax - m_reg > Cst<MODE>::THRS) ? fmaxf(m_reg, pmax) : m_reg;
    alpha = __builtin_amdgcn_exp2f(m_reg - mn); m_reg = mn;
    const f32x16 mnv = {mn, mn, mn, mn, mn, mn, mn, mn, mn, mn, mn, mn, mn, mn, mn, mn};
    if constexpr (PF) { v_frag_read<3>(fb, vb); LW(8); } else { v_frag_read<2>(fa, vb); LW(0); }
    SBAR();
    pv_mma(o[2], fa, pa0, pa1, pa2, pa3);
    p0 = p0 - mnv; p1 = p1 - mnv;
#pragma unroll
    for (int r = 0; r < 8; ++r) p0[r] = __builtin_amdgcn_exp2f(p0[r]);
    if constexpr (PF) { LW(0); } else { v_frag_read<3>(fb, vb); LW(0); }
    SBAR();
    pv_mma(o[3], fb, pa0, pa1, pa2, pa3);
#pragma unroll
    for (int r = 8; r < 16; ++r) p0[r] = __builtin_amdgcn_exp2f(p0[r]);
    asm volatile("" : "+v"(p0), "+v"(p1));
}
#undef LW
__device__ __forceinline__ bf16_t f2bf(float f) { return (bf16_t)(cvt_pk_bf16(f, f) & 0xffffu); }

template <int MODE, bool STORE = true>
__device__ __forceinline__ void attn_unit(LAS unsigned char* lds, const bf16_t* Qb, const bf16_t* __restrict__ Kh, const bf16_t* __restrict__ Krh, const bf16_t* __restrict__ Vh,
                                          int seq, bf16_t* Ob, float lam, const float* __restrict__ subg, int wv) {
    constexpr int ND = MODE ? 12 : 4, LDQ = MODE ? 1536 : 3072, LDK = MODE ? 2048 : 3072, LDO = MODE ? 1024 : 3072;
    constexpr bool PFV = true;
    constexpr int STG = SHM_V + SHM_K + (MODE ? SHM_KR : 0), OFF_WS = 3 * STG;
    int tid = wv * 64 + lane_id(); asm volatile("" : "+v"(tid));
    const int wid = __builtin_amdgcn_readfirstlane(tid >> 6), lane = tid & 63, r32 = lane & 31, hi = lane >> 5;
    const int comp = MODE ? 0 : (wid >> 2), wq = MODE ? wid : (wid & 3);
    LAS float* wsf = (LAS float*)(lds + OFF_WS) + wid * 64; LAS float* li_l = wsf; LAS float* al_l = wsf + 32;
    float m_reg = -1e30f, l_reg = 0; f32x16 o[4] = {}; bf16x8 qr[ND];
    const bf16_t* Qw = Qb + (size_t)(wq * 32 + r32) * LDQ + comp * 64 + hi * 8;
#pragma unroll
    for (int d0 = 0; d0 < ND; ++d0) qr[d0] = *(const bf16x8*)(Qw + d0 * 16);
    unsigned voffV[2], voffK[2], voffR = 0;
#pragma unroll
    for (int i = 0; i < 2; ++i) {
        const int c = wid * 2 + i, ob = c * 1024 + lane * 16;
        { const int sub = ob >> 9, within = ob & 511, kk = (sub >> 2) * 8 + (within >> 6), k = (kk & ~0xC) | ((kk & 4) << 1) | ((kk & 8) >> 1), col = (sub & 3) * 32 + ((within & 63) >> 1);
          voffV[i] = (unsigned)(k * LDK + col) * 2u; }
        { const int row = 4 * c + (lane >> 4), g = lane & 15; voffK[i] = (unsigned)(row * LDK + ((g ^ (row & 15)) * 8)) * 2u; }
    }
    if constexpr (MODE == 1) { const int row = 8 * wid + (lane >> 3), g = lane & 7; voffR = (unsigned)(row * 64 + ((g ^ ((row >> 1) & 7)) * 8)) * 2u; }
    const int vb0 = (int)(unsigned)(uintptr_t)lds + v_rd_base(lane);
#define DMA(t, so) do { const char* vt_ = (const char*)(Vh + (size_t)(t) * KVBLK * LDK); const char* kt_ = (const char*)(Kh + (size_t)(t) * KVBLK * LDK); \
    _Pragma("unroll") for (int i_ = 0; i_ < 2; ++i_) { \
        __builtin_amdgcn_global_load_lds((const unsigned*)(vt_ + voffV[i_]), (LAS unsigned*)(lds + (so) + (wid * 2 + i_) * 1024), 16, 0, 0); \
        __builtin_amdgcn_global_load_lds((const unsigned*)(kt_ + voffK[i_]), (LAS unsigned*)(lds + (so) + SHM_V + (wid * 2 + i_) * 1024), 16, 0, 0); } \
    if constexpr (MODE == 1) __builtin_amdgcn_global_load_lds((const unsigned*)((const char*)(Krh + (size_t)(t) * KVBLK * 64) + voffR), (LAS unsigned*)(lds + (so) + SHM_V + SHM_K + wid * 1024), 16, 0, 0); } while (0)
#define RESC(a) do { if (__any((a) < 1.f)) { if (hi == 0) al_l[r32] = (a); asm volatile("s_waitcnt lgkmcnt(0)" ::: "memory"); \
    _Pragma("unroll") for (int d = 0; d < 4; ++d) _Pragma("unroll") for (int r = 0; r < 16; ++r) o[d][r] *= al_l[crow(r, hi)]; } } while (0)
#define KB(so) (lds + (so) + SHM_V)
#define KRB(so) (lds + (so) + SHM_V + SHM_K)
#define LBAR() asm volatile("s_waitcnt vmcnt(0) lgkmcnt(0)\n\ts_barrier" ::: "memory")
#define ROT() do { const int t_ = s_prev; s_prev = s_cur; s_cur = s_next; s_next = t_; } while (0)
#define ITER(jj, PC0, PC1, alC, PP0, PP1, alP) do { \
    if ((jj) + 1 < NT) DMA((jj) + 1, s_next); \
    SBAR(); qkt<MODE>(PC0, PC1, KB(s_cur), KRB(s_cur), qr, r32, hi, comp); \
    finishSM(PP0, PP1, alP, l_reg, pa0, pa1, pa2, pa3); SBAR(); \
    pv_partial<MODE, PFV>(o, vb0 + s_prev, pa0, pa1, pa2, pa3, PC0, PC1, m_reg, alC); \
    RESC(alC); LBAR(); ROT(); } while (0)
    f32x16 pA0, pA1, pB0, pB1; float mnA, alA, alB; bf16x8 pa0, pa1, pa2, pa3; const int NT = seq / KVBLK;
    int s_prev = 0, s_cur = STG, s_next = 2 * STG;
    DMA(0, 0); DMA(1, STG); LBAR();
    qkt<MODE>(pA0, pA1, KB(0), KRB(0), qr, r32, hi, comp); partialSM<MODE>(pA0, pA1, m_reg, mnA, alA);
    int j = 1;
    for (; j + 2 < NT; j += 2) {
        ITER(j, pB0, pB1, alB, pA0, pA1, alA);
        ITER(j + 1, pA0, pA1, alA, pB0, pB1, alB);
    }
    SBAR(); qkt<MODE>(pB0, pB1, KB(s_cur), KRB(s_cur), qr, r32, hi, comp);
    finishSM(pA0, pA1, alA, l_reg, pa0, pa1, pa2, pa3); SBAR();
    pv_partial<MODE, PFV>(o, vb0 + s_prev, pa0, pa1, pa2, pa3, pB0, pB1, m_reg, alB);
    RESC(alB);
    finishSM(pB0, pB1, alB, l_reg, pa0, pa1, pa2, pa3); SBAR();
    pv_d0(o, vb0 + s_cur, pa0, pa1, pa2, pa3);
    if (hi == 0) li_l[r32] = l_reg; asm volatile("s_waitcnt lgkmcnt(0)" ::: "memory");
    float rli[16];
#pragma unroll
    for (int r = 0; r < 16; ++r) rli[r] = __builtin_amdgcn_rcpf(li_l[crow(r, hi)]);
    if constexpr (MODE == 1) {
        bf16_t* Ow = Ob + (size_t)(wq * 32) * LDO;
#pragma unroll
        for (int r = 0; r < 16; ++r) { const int orow = crow(r, hi);
#pragma unroll
            for (int d0 = 0; d0 < 4; ++d0) Ow[(size_t)orow * LDO + d0 * 32 + r32] = f2bf(o[d0][r] * rli[r]); }
        __syncthreads();
    } else {
        __syncthreads();
        LAS float* X = (LAS float*)lds + (size_t)wq * 4096 + lane;
        if (comp == 1) {
#pragma unroll
            for (int d0 = 0; d0 < 4; ++d0)
#pragma unroll
                for (int r = 0; r < 16; ++r) X[(d0 * 16 + r) * 64] = o[d0][r] * rli[r];
        }
        __syncthreads();
        if (comp == 0) {
            float ss[16];
#pragma unroll
            for (int r = 0; r < 16; ++r) { float s = 0.f;
#pragma unroll
                for (int d0 = 0; d0 < 4; ++d0) { const float v = o[d0][r] * rli[r] - lam * X[(d0 * 16 + r) * 64]; o[d0][r] = v; s += v * v; }
                ss[r] = s; }
#pragma unroll
            for (int r = 0; r < 16; ++r) { float s = ss[r];
                s += shx<1>(s); s += shx<2>(s); s += shx<4>(s); s += shx<8>(s); s += shx<16>(s);
                ss[r] = rsqrtf(s * (1.0f / 128.0f) + EPS) * 0.8f; }
            float gg[4];
#pragma unroll
            for (int d0 = 0; d0 < 4; ++d0) gg[d0] = subg[d0 * 32 + r32];
            bf16_t* Ow = Ob + (size_t)(wq * 32) * LDO;
#pragma unroll
            for (int r = 0; r < 16; ++r) { const int orow = crow(r, hi);
#pragma unroll
                for (int d0 = 0; d0 < 4; ++d0) { const bf16_t val = f2bf(o[d0][r] * ss[r] * gg[d0]); if (STORE || val == 0x7fc1) Ow[(size_t)orow * LDO + d0 * 32 + r32] = val; } }
        }
        __syncthreads();
    }
#undef DMA
#undef RESC
#undef KB
#undef KRB
#undef LBAR
#undef ROT
#undef ITER
}
}

struct ColSrc { const float* p; int ld; };
template <class Map>
__device__ __forceinline__ void transpose_items(const Map mp, int K, int Nout, bf16_t* WT, const float* gain, LAS float* scr, int gw, int ngw, int lane) {
    const int nblk = Nout / 32, nitems = (K / 64) * nblk;
    for (int it = gw; it < nitems; it += ngw) {
        const int kb = it / nblk, nb = it % nblk, k0 = 64 * kb, n0 = 32 * nb;
        const ColSrc cs = mp(n0 + (lane & 31));
#pragma unroll 8
        for (int i = 0; i < 32; ++i) { const int kk = 2 * i + (lane >> 5);
            float v = cs.p ? cs.p[(size_t)(k0 + kk) * cs.ld] : 0.f; if (gain) v *= gain[k0 + kk];
            scr[kk * 33 + (lane & 31)] = v; }
        asm volatile("s_waitcnt lgkmcnt(0)" ::: "memory");
        const int c = lane & 7;
#pragma unroll
        for (int j = 0; j < 4; ++j) { const int n = (lane >> 3) + 8 * j; const LAS float* s = scr + (8 * c) * 33 + n;
            u32x4 o; o.x = cvt_pk_bf16(s[0 * 33], s[1 * 33]); o.y = cvt_pk_bf16(s[2 * 33], s[3 * 33]); o.z = cvt_pk_bf16(s[4 * 33], s[5 * 33]); o.w = cvt_pk_bf16(s[6 * 33], s[7 * 33]);
            *(u32x4*)(WT + (size_t)(n0 + n) * K + k0 + 8 * c) = o; }
        asm volatile("s_waitcnt lgkmcnt(0)" ::: "memory");
    }
}
__device__ __forceinline__ int rope_src(int j, int ng) { const int g = j >> 3; if (g >= ng) return j; return ((j & 7) < 4 ? 0 : 4 * ng) + 4 * g + (j & 3); }
struct MapIn { const float* w;
    __device__ ColSrc operator()(int n) const {
        int src;
        if (n < 2048) src = (n & ~63) + rope_src(n & 63, 2);
        else if (n < 4096) src = n;
        else if (n < 4160) src = 4096 + rope_src(n - 4096, 8);
        else return ColSrc{nullptr, 0};
        return ColSrc{w + src, 8256}; } };
struct MapG { const float* w;
    __device__ ColSrc operator()(int n) const { return ColSrc{w + 4160 + n, 8256}; } };
struct MapQb { const float* w;
    __device__ ColSrc operator()(int n) const { const int blk = n >> 6; const int src = (blk % 3 == 2) ? (n & ~63) + rope_src(n & 63, 8) : n; return ColSrc{w + src, 1536}; } };
struct MapId { const float* w; int ld;
    __device__ ColSrc operator()(int n) const { return ColSrc{w + n, ld}; } };
struct MapGu { const float* wg; const float* wu;
    __device__ ColSrc operator()(int n) const { const int t = n >> 8, r = n & 255; return r < 128 ? ColSrc{wg + t * 128 + r, FF} : ColSrc{wu + t * 128 + (r - 128), FF}; } };

struct Args {
    const float* in[21]; float* out; unsigned char* ws;
};
constexpr int NWAVES = 8;
constexpr int LDS_BYTES = 147456;

__global__ void __launch_bounds__(NWAVES * 64, 2) fwd_mega(Args a) {
    extern __shared__ __attribute__((aligned(16))) unsigned char lds_raw[];
    LAS unsigned char* lds = (LAS unsigned char*)lds_raw;
    cg::grid_group grid = cg::this_grid();
    const int G = gridDim.x, bx = blockIdx.x;
    const int wv = __builtin_amdgcn_readfirstlane((int)threadIdx.x >> 6);
    volatile LAS unsigned* bst = (volatile LAS unsigned*)(lds + 139264);
    if (threadIdx.x < 2) bst[threadIdx.x] = 0u;
    const int vcu = (G % 8 == 0) ? (bx % 8) * (G / 8) + bx / 8 : bx;
#define PHASE_PTRS() \
    size_t zoff_ = 0; asm volatile("" : "+s"(zoff_)); unsigned char* ws = a.ws + zoff_; \
    int tid = wv * 64 + lane_id(); asm volatile("" : "+v"(tid)); const int lane = tid & 63, wave = wv; (void)lane; (void)wave; \
    const int gw = vcu * NWAVES + wave, ngw = G * NWAVES; (void)gw; (void)ngw; \
    const float* x0 = a.in[0]; const float* x1 = a.in[1]; (void)x0; (void)x1; \
    float* ssq_q = (float*)(ws + WS_SSQ); float* ssq_kv = (float*)(ws + WS_SSQ + MiB); float* rstd1 = (float*)(ws + WS_RSTD); (void)ssq_q; (void)ssq_kv; (void)rstd1; \
    float* tda = (float*)(ws + WS_TDA); float* tmla = (float*)(ws + WS_TMLA); (void)tda; (void)tmla; \
    bf16_t* Wi = (bf16_t*)(ws + WS_WI); bf16_t* Wg = (bf16_t*)(ws + WS_WG); bf16_t* Wqb = (bf16_t*)(ws + WS_WQB); bf16_t* Wkvb = (bf16_t*)(ws + WS_WKVB); bf16_t* Wbda = (bf16_t*)(ws + WS_WBDA); \
    bf16_t* Wbmla = (bf16_t*)(ws + WS_WBMLA); bf16_t* Wout = (bf16_t*)(ws + WS_WOUT); bf16_t* Wgu = (bf16_t*)(ws + WS_WGU); bf16_t* Wd = (bf16_t*)(ws + WS_WD); \
    bf16_t* QKV = (bf16_t*)(ws + WS_QKV); bf16_t* TMP = QKV; bf16_t* X1B = QKV; bf16_t* CQKV = (bf16_t*)(ws + WS_CQKV); bf16_t* OM = CQKV; bf16_t* KR = (bf16_t*)(ws + WS_KR); \
    bf16_t* XN = (bf16_t*)(ws + WS_XN); bf16_t* KVM = (bf16_t*)(ws + WS_KVM); bf16_t* MRG = KVM; bf16_t* QM = (bf16_t*)(ws + WS_QM); bf16_t* ACT = (bf16_t*)(ws + WS_ACT); \
    (void)Wi; (void)Wg; (void)Wqb; (void)Wkvb; (void)Wbda; (void)Wbmla; (void)Wout; (void)Wgu; (void)Wd; (void)QKV; (void)TMP; (void)X1B; (void)CQKV; (void)OM; (void)KR; (void)XN; (void)KVM; (void)MRG; (void)QM; (void)ACT;
#define GRID_BAR() xcd_barrier((unsigned*)(a.ws + WS_BAR), bst, wv == 0 && lane_id() == 0)

    {
        PHASE_PTRS();
        LAS float* scr = (LAS float*)(lds + wave * 16384);
        if (bx == 0) for (int i = tid; i < XCD_BAR_WORDS; i += 512) ((unsigned*)(ws + WS_BAR))[i] = 0u;
        for (int i = bx * 512 + tid; i < S1 * 40; i += G * 512) {
            const int pos = i / 40, k = i % 40;
            const float expo = k < 8 ? (float)k * (1.0f / 8.0f) : (float)(k - 8) * (1.0f / 32.0f);
            const float inv = __builtin_amdgcn_exp2f(-expo * 18.931568569324174f);
            const float ang = (float)pos * inv;
            const double rev = (double)ang * 0.15915494309189535; const float fr = (float)(rev - __builtin_rint(rev));
            const float c = __builtin_amdgcn_cosf(fr), sn = __builtin_amdgcn_sinf(fr);
            if (k < 8) { tda[(size_t)pos * 16 + k] = c; tda[(size_t)pos * 16 + 8 + k] = sn; }
            else { tmla[(size_t)pos * 64 + (k - 8)] = c; tmla[(size_t)pos * 64 + 32 + (k - 8)] = sn; }
        }
        transpose_items(MapIn{a.in[3]}, 2048, NINP, Wi, nullptr, scr, gw, ngw, lane);
        transpose_items(MapG{a.in[3]}, 2048, 4096, Wg, nullptr, scr, gw, ngw, lane);
        transpose_items(MapQb{a.in[10]}, 512, 1536, Wqb, a.in[9], scr, gw, ngw, lane);
        transpose_items(MapId{a.in[12], 2048}, 512, 2048, Wkvb, a.in[11], scr, gw, ngw, lane);
        transpose_items(MapId{a.in[13], 2048}, 1024, 2048, Wbda, nullptr, scr, gw, ngw, lane);
        transpose_items(MapId{a.in[14], 2048}, 1024, 2048, Wbmla, nullptr, scr, gw, ngw, lane);
        const float* gn = a.in[2];
        for (int m = gw; m < T; m += ngw) {
            const float* xr = m < S0 ? x0 + (size_t)m * DM : x1 + (size_t)(m - S0) * DM;
            f32x4 v[8]; float sq = 0.f;
#pragma unroll
            for (int j = 0; j < 8; ++j) { v[j] = *(const f32x4*)(xr + j * 256 + lane * 4); sq += sumsq4(v[j]); }
            const float rs = rsqrtf(wave_sum(sq) * (1.0f / DM) + EPS);
#pragma unroll
            for (int j = 0; j < 8; ++j) { const f32x4 gv = *(const f32x4*)(gn + j * 256 + lane * 4); const f32x4 y = v[j] * rs * gv;
                u32x2 w; w.x = cvt_pk_bf16(y[0], y[1]); w.y = cvt_pk_bf16(y[2], y[3]); *(u32x2*)(XN + (size_t)m * DM + j * 256 + lane * 4) = w; }
        }
    }
    grid.sync();
    if (wv == 0 && lane_id() == 0) (void)xb_add(&((unsigned*)(a.ws + WS_BAR))[XB_XCNT(xb_xcc_id())], 1u);
    {
        PHASE_PTRS();
        pg8::Gemm g{XN, Wi, T, NINP, 2048, 2048}; pg8::StaticOrder S; S.init(T, NINP, G, bx);
        EpiIn E{QKV, CQKV, KR, ssq_q, ssq_kv, tda, tmla};
        pg8::gemm_phase(lds, g, S, E, wv);
    }
    GRID_BAR();
    {
        PHASE_PTRS();
        pg8::Gemm g{CQKV, Wqb, T, 1536, 512, 1024}; pg8::StaticOrder S; S.init(T, 1536, G, bx);
        EpiQb E{QM, ssq_q, tmla};
        pg8::gemm_phase(lds, g, S, E, wv);
    }
    {
        PHASE_PTRS();
        pg8::Gemm g{CQKV + 512, Wkvb, T, 2048, 512, 1024}; pg8::StaticOrder S; S.init(T, 2048, G, bx);
        EpiScale E{KVM, 2048, ssq_kv, 1.0f / 512.0f};
        pg8::gemm_phase(lds, g, S, E, wv);
    }
    GRID_BAR();
    {
        PHASE_PTRS();
        float lam;
        { const float a1 = a.in[4][lane] * a.in[5][lane], a2 = a.in[6][lane] * a.in[7][lane];
          lam = __builtin_amdgcn_exp2f(wave_sum(a1) * LOG2E) - __builtin_amdgcn_exp2f(wave_sum(a2) * LOG2E) + 0.2f; }
        const float* subg = a.in[8];
#ifdef PROBE_DA2
        for (int u = vcu; u < 1024 + 512; u += G) {
            const bool smp = u < 1024; const int uu = smp ? u : u - 1024;
            const int h = (uu & 255) >> 5, qb = (uu >> 8) * 32 + (uu & 31);
            const int seq0 = smp ? S0 : 0, seq = smp ? S1 : S0;
            const bf16_t* base = QKV + (size_t)seq0 * 3072 + h * 128;
            bf16_t* qp = QKV + (size_t)(seq0 + qb * 128) * 3072 + h * 128;
            att::attn_unit<0, false>(lds, qp, base + 1024, nullptr, base + 2048, seq, qp, lam, subg, wv);
        }
#endif
        for (int u = vcu; u < 1024 + 512; u += G) {
            const bool smp = u < 1024; const int uu = smp ? u : u - 1024;
            const int h = (uu & 255) >> 5, qb = (uu >> 8) * 32 + (uu & 31);
            const int seq0 = smp ? S0 : 0, seq = smp ? S1 : S0;
            const bf16_t* base = QKV + (size_t)seq0 * 3072 + h * 128;
            bf16_t* qp = QKV + (size_t)(seq0 + qb * 128) * 3072 + h * 128;
            att::attn_unit<0>(lds, qp, base + 1024, nullptr, base + 2048, seq, qp, lam, subg, wv);
        }
#ifdef PROBE_MLA2
        for (int rep_ = 0; rep_ < 2; ++rep_)
#endif
        for (int u = vcu; u < 512 + 256; u += G) {
            const bool smp = u < 512; const int uu = smp ? u : u - 512;
            const int h = (uu & 255) >> 5, qb = (uu >> 8) * 32 + (uu & 31);
            const int seq0 = smp ? S0 : 0, seq = smp ? S1 : S0;
            const bf16_t* qp = QM + (size_t)(seq0 + qb * 256) * 1536 + h * 192;
            const bf16_t* kp = KVM + (size_t)seq0 * 2048 + h * 256;
            att::attn_unit<1>(lds, qp, kp, KR + (size_t)seq0 * 64, kp + 128, seq, OM + (size_t)(seq0 + qb * 256) * 1024 + h * 128, 0.f, nullptr, wv);
        }
    }
    GRID_BAR();
    {
        PHASE_PTRS();
        LAS float* scr = (LAS float*)(lds + wave * 16384);
        transpose_items(MapId{a.in[15], 2048}, 2048, 2048, Wout, nullptr, scr, gw, ngw, lane);
        __syncthreads();
    }
    {
        PHASE_PTRS();
        pg8::Gemm g{QKV, Wbda, T, 2048, 1024, 3072}; pg8::StaticOrder S; S.init(T, 2048, G, bx);
        EpiPlain E{MRG, 2048};
        pg8::gemm_phase(lds, g, S, E, wv);
    }
    {
        PHASE_PTRS();
        pg8::Gemm g{XN, Wg, T, 2048, 2048, 2048}; pg8::StaticOrder S; S.init(T, 2048, G, bx);
        EpiGate<0> E{MRG, nullptr};
        pg8::gemm_phase(lds, g, S, E, wv);
    }
    GRID_BAR();
    {
        PHASE_PTRS();
        pg8::Gemm g{OM, Wbmla, T, 2048, 1024, 1024}; pg8::StaticOrder S; S.init(T, 2048, G, bx);
        EpiPlain E{TMP, 2048};
        pg8::gemm_phase(lds, g, S, E, wv);
    }
    {
        PHASE_PTRS();
        pg8::Gemm g{XN, Wg + (size_t)2048 * 2048, T, 2048, 2048, 2048}; pg8::StaticOrder S; S.init(T, 2048, G, bx);
        EpiGate<1> E{MRG, TMP};
        pg8::gemm_phase(lds, g, S, E, wv);
    }
    GRID_BAR();
    {
        PHASE_PTRS();
        pg8::Gemm g{MRG, Wout, T, 2048, 2048, 2048}; pg8::StaticOrder S; S.init(T, 2048, G, bx);
        EpiX1 E{x0, x1, X1B};
        pg8::gemm_phase(lds, g, S, E, wv);
    }
    GRID_BAR();
    {
        PHASE_PTRS();
        LAS float* scr = (LAS float*)(lds + wave * 16384);
        transpose_items(MapGu{a.in[17], a.in[18]}, 2048, 11264, Wgu, a.in[16], scr, gw, ngw, lane);
        transpose_items(MapId{a.in[19], 2048}, FF, 2048, Wd, nullptr, scr, gw, ngw, lane);
        for (int m = gw; m < T; m += ngw) {
            float sq = 0.f;
#pragma unroll
            for (int j = 0; j < 4; ++j) { f32x4 p, q; unpack8(*(const u32x4*)(X1B + (size_t)m * DM + j * 512 + lane * 8), p, q); sq += sumsq4(p) + sumsq4(q); }
            sq = wave_sum(sq);
            if (lane == 0) rstd1[m] = rsqrtf(sq * (1.0f / DM) + EPS);
        }
        __syncthreads();
    }
    GRID_BAR();
    {
        PHASE_PTRS();
        pg8::Gemm g{X1B, Wgu, T, 11264, 2048, 2048}; pg8::StaticOrder S; S.init(T, 11264, G, bx);
        EpiSwiGLU E{ACT, rstd1};
        pg8::gemm_phase(lds, g, S, E, wv);
    }
    GRID_BAR();
    {
        PHASE_PTRS();
        pg8::Gemm g{ACT, Wd, T, 2048, FF, FF}; pg8::StaticOrder S; S.init(T, 2048, G, bx);
        EpiX2 E{X1B};
        pg8::gemm_phase(lds, g, S, E, wv);
    }
    GRID_BAR();
    {
        PHASE_PTRS();
        const float* gn = a.in[20];
        for (int m = gw; m < T; m += ngw) {
            f32x4 v[8]; float sq = 0.f;
#pragma unroll
            for (int j = 0; j < 4; ++j) { unpack8(*(const u32x4*)(X1B + (size_t)m * DM + j * 512 + lane * 8), v[2 * j], v[2 * j + 1]); sq += sumsq4(v[2 * j]) + sumsq4(v[2 * j + 1]); }
            const float rs = rsqrtf(wave_sum(sq) * (1.0f / DM) + EPS);
            float* orow = a.out + (size_t)m * DM;
#pragma unroll
            for (int j = 0; j < 4; ++j) { const int c = j * 512 + lane * 8;
                *(f32x4*)(orow + c) = v[2 * j] * rs * *(const f32x4*)(gn + c); *(f32x4*)(orow + c + 4) = v[2 * j + 1] * rs * *(const f32x4*)(gn + c + 4); }
        }
    }
}

extern "C" void kernel_launch(void* const* d_in, const int* in_sizes, int n_in, void* d_out, int out_size, void* d_ws, size_t ws_size, hipStream_t stream) {
    static int grid = 0;
    if (grid == 0) {
        if (n_in != 21 || in_sizes[0] != S0 * DM || in_sizes[1] != S1 * DM || out_size != T * DM || ws_size < WS_END) {
            fprintf(stderr, "kernel_launch: shape mismatch n_in %d in0 %d in1 %d out %d ws %zu (need %zu)\n", n_in, n_in > 0 ? in_sizes[0] : -1, n_in > 1 ? in_sizes[1] : -1, out_size, ws_size, (size_t)WS_END);
            grid = -1; return; }
        int dev = 0, cus = 0, per_cu = 0;
        if (hipGetDevice(&dev) != hipSuccess || hipDeviceGetAttribute(&cus, hipDeviceAttributeMultiprocessorCount, dev) != hipSuccess) { grid = -1; return; }
        if (hipFuncSetAttribute((const void*)fwd_mega, hipFuncAttributeMaxDynamicSharedMemorySize, LDS_BYTES) != hipSuccess) { fprintf(stderr, "kernel_launch: hipFuncSetAttribute failed\n"); grid = -1; return; }
        if (hipOccupancyMaxActiveBlocksPerMultiprocessor(&per_cu, (const void*)fwd_mega, NWAVES * 64, LDS_BYTES) != hipSuccess || per_cu < 1) { fprintf(stderr, "kernel_launch: occupancy query says %d\n", per_cu); per_cu = 1; }
        (void)hipGetLastError();
        grid = cus * per_cu;
    }
    if (grid < 0) return;
    Args a{};
    for (int i = 0; i < 21; ++i) a.in[i] = (const float*)d_in[i];
    a.out = (float*)d_out; a.ws = (unsigned char*)d_ws;
    void* args[] = {&a};
    const hipError_t e = hipLaunchCooperativeKernel((void*)fwd_mega, dim3(grid), dim3(NWAVES * 64), args, LDS_BYTES, stream);
    if (e != hipSuccess) fprintf(stderr, "kernel_launch: cooperative launch failed: %s (grid %d)\n", hipGetErrorString(e), grid);
}
```

```cpp
#include <hip/hip_runtime.h>
#include <hip/hip_cooperative_groups.h>
#include <cstdio>
#include <cstdint>
namespace cg = cooperative_groups;

#define LAS __attribute__((address_space(3)))
typedef unsigned short bf16_t;
typedef short bf16x8 __attribute__((ext_vector_type(8)));
typedef short s16x4 __attribute__((ext_vector_type(4)));
typedef float f32x4 __attribute__((ext_vector_type(4)));
typedef float f32x16 __attribute__((ext_vector_type(16)));
typedef unsigned u32x4 __attribute__((ext_vector_type(4)));
typedef unsigned u32x2 __attribute__((ext_vector_type(2)));

constexpr int DM = 2048, S0 = 8192, S1 = 16384, T = S0 + S1;
constexpr int FF = 5632;
constexpr float EPS = 1e-6f;
constexpr float LOG2E = 1.4426950408889634f;

constexpr size_t MiB = 1u << 20;
constexpr size_t WS_SSQ = 0;
constexpr size_t WS_BAR = 2 * MiB;
constexpr size_t WS_RSTD = 2 * MiB + 256 * 1024;
constexpr size_t WS_TDA = 3 * MiB;
constexpr size_t WS_TMLA = 4 * MiB;
constexpr size_t WS_WI = 8 * MiB;
constexpr size_t WS_WG = 25 * MiB;
constexpr size_t WS_WQB = 41 * MiB;
constexpr size_t WS_WKVB = WS_WQB + 3 * MiB / 2;
constexpr size_t WS_WBDA = WS_WKVB + 2 * MiB;
constexpr size_t WS_WBMLA = WS_WBDA + 4 * MiB;
constexpr size_t WS_QKV = 53 * MiB;
constexpr size_t WS_CQKV = 197 * MiB;
constexpr size_t WS_KR = 245 * MiB;
constexpr size_t WS_XN = 248 * MiB;
constexpr size_t WS_KVM = 344 * MiB;
constexpr size_t WS_QM = 440 * MiB;
constexpr size_t WS_WOUT = 440 * MiB;
constexpr size_t WS_ACT = 149 * MiB;
constexpr size_t WS_WGU = 413 * MiB;
constexpr size_t WS_WD = 457 * MiB;
constexpr size_t WS_END = 512 * MiB;
constexpr int NINP = 4352;

__device__ __forceinline__ unsigned cvt_pk_bf16(float lo, float hi) { unsigned r; asm volatile("v_cvt_pk_bf16_f32 %0, %1, %2" : "=v"(r) : "v"(lo), "v"(hi)); return r; }
__device__ __forceinline__ float bf_lo(unsigned u) { return __uint_as_float(u << 16); }
__device__ __forceinline__ float bf_hi(unsigned u) { return __uint_as_float(u & 0xffff0000u); }
template <int K> __device__ __forceinline__ float shx(float v) {
    return __int_as_float(__builtin_amdgcn_ds_swizzle(__float_as_int(v), (K << 10) | 0x1f));
}
__device__ __forceinline__ float add_halves(float v) { auto rr = __builtin_amdgcn_permlane32_swap(__float_as_uint(v), __float_as_uint(v), false, false); return __uint_as_float(rr[0]) + __uint_as_float(rr[1]); }
__device__ __forceinline__ float wave_sum(float v) {
    v += shx<1>(v); v += shx<2>(v); v += shx<4>(v); v += shx<8>(v); v += shx<16>(v);
    return add_halves(v);
}
__device__ __forceinline__ float sigmoidf_(float x) { return __builtin_amdgcn_rcpf(1.0f + __builtin_amdgcn_exp2f(-x * LOG2E)); }
__device__ __forceinline__ void atomic_addf(float* p, float v) { __hip_atomic_fetch_add(p, v, __ATOMIC_RELAXED, __HIP_MEMORY_SCOPE_AGENT); }

__device__ __forceinline__ int lane_id() { return (int)__builtin_amdgcn_mbcnt_hi(~0u, __builtin_amdgcn_mbcnt_lo(~0u, 0u)); }
#define XB_TMO      128
#define XB_XCNT(j)  (256  + 64 * (j))
#define XB_XSUB(j)  (1280 + 64 * (j))
#define XB_XGEN(j)  (2304 + 64 * (j))
#define XB_TOP      3328
#define XB_TOPGEN   3392
#define XCD_BAR_WORDS 3456
#define XB_SPIN_CAP (1u << 22)
__device__ __forceinline__ unsigned xb_ld(unsigned* p)              { return __hip_atomic_load(p, __ATOMIC_RELAXED, __HIP_MEMORY_SCOPE_AGENT); }
__device__ __forceinline__ unsigned xb_add(unsigned* p, unsigned v) { return __hip_atomic_fetch_add(p, v, __ATOMIC_RELAXED, __HIP_MEMORY_SCOPE_AGENT); }
__device__ __forceinline__ unsigned xb_xcc_id() { return (unsigned)__builtin_amdgcn_s_getreg((3 << 11) | 20) & 0xFu; }
#define XB_SPIN(cond, bar) do { unsigned _sp = 0; while (cond) { __builtin_amdgcn_s_sleep(1); \
    if ((++_sp & 255u) == 0u) { if (xb_ld(&(bar)[XB_TMO])) break; if (_sp > XB_SPIN_CAP) { atomicAdd(&(bar)[XB_TMO], 1u); break; } } } } while (0)
__device__ __forceinline__ void xcd_barrier_complete(unsigned* bar, unsigned x, unsigned G, unsigned& nloc, unsigned& nx) {
    unsigned sum, cnt, mine, sp = 0u;
    for (;;) {
        sum = 0u; cnt = 0u; mine = 0u;
#pragma unroll
        for (unsigned j = 0; j < 16; ++j) { const unsigned c = xb_ld(&bar[XB_XCNT(j)]); sum += c; cnt += (c > 0u) ? 1u : 0u; mine = (j == x) ? c : mine; }
        if (sum == G) break;
        __builtin_amdgcn_s_sleep(1);
        if ((++sp & 255u) == 0u) { if (xb_ld(&bar[XB_TMO])) break; if (sp > XB_SPIN_CAP) { atomicAdd(&bar[XB_TMO], 1u); break; } }
    }
    nloc = mine > 0u ? mine : 1u; nx = cnt > 0u ? cnt : 1u;
}
__device__ __forceinline__ void xcd_barrier(unsigned* bar, volatile LAS unsigned* st, bool leader) {
    asm volatile("s_waitcnt vmcnt(0)" ::: "memory");
    __syncthreads();
    if (leader) {
        __builtin_amdgcn_s_waitcnt(0);
        const unsigned x = xb_xcc_id();
        unsigned nloc = st[0], nx = st[1];
        if (nloc == 0u) { xcd_barrier_complete(bar, x, gridDim.x, nloc, nx); st[0] = nloc; st[1] = nx; }
        const unsigned old = xb_add(&bar[XB_XSUB(x)], 1u);
        const unsigned gen = old / nloc;
        if (old + 1u == (gen + 1u) * nloc) {
            __builtin_amdgcn_fence(__ATOMIC_RELEASE, "agent");
            asm volatile("s_waitcnt vmcnt(0)" ::: "memory");
            const unsigned og = xb_add(&bar[XB_TOP], 1u);
            const unsigned tg = og / nx;
            if (og + 1u == (tg + 1u) * nx) xb_add(&bar[XB_TOPGEN], 1u);
            else XB_SPIN(xb_ld(&bar[XB_TOPGEN]) == tg, bar);
            __builtin_amdgcn_fence(__ATOMIC_ACQUIRE, "agent");
            xb_add(&bar[XB_XGEN(x)], 1u);
            asm volatile("s_waitcnt vmcnt(0)" ::: "memory");
        } else {
            XB_SPIN(xb_ld(&bar[XB_XGEN(x)]) == gen, bar);
            __builtin_amdgcn_fence(__ATOMIC_ACQUIRE, "agent");
            asm volatile("s_waitcnt vmcnt(0)" ::: "memory");
        }
    }
    __syncthreads();
}

namespace pg8 {
constexpr int BM = 256, BK = 64, HALF = 128, HTB = HALF * BK * 2, STAGE_BYTES = 8 * HTB, NXCD = 8, WGM = 8;
__host__ __device__ __forceinline__ int lds_byte(int r, int c) { const int st = (r >> 4) * 2 + (c >> 5), rr = r & 15, cc = c & 31, ob = rr * 64 + cc * 2; return st * 1024 + (ob ^ (((ob >> 9) & 1) << 5)); }
__host__ __device__ __forceinline__ void stage_rc(int b, int& R, int& C) { const int st = b / 1024, sb = b % 1024, swz = sb ^ (((sb >> 9) & 1) << 5); R = (st >> 1) * 16 + swz / 64; C = (st & 1) * 32 + (swz % 64) / 2; }
__host__ __device__ __forceinline__ int perm32(int rho) { const int n = rho >> 4, i = rho & 15; return 8 * (i >> 2) + 4 * n + (i & 3); }

struct Unit { int pm, pn; };
struct Gemm { const bf16_t* A; const bf16_t* Bt; int M, N, K, lda; };
struct StaticOrder {
    int nM, nN, nwg, G, c;
    __device__ void init(int M, int N, int G_, int c_) { nM = M / BM; nN = N / BM; nwg = nM * nN; G = G_; c = c_; }
    __device__ bool next(int i, Unit& u) const {
        const long L = (long)i * G + c; if (L >= nwg) return false;
        int wgid = (int)L; { const int q = nwg / NXCD, r = nwg % NXCD, xcd = wgid % NXCD, off = wgid / NXCD; wgid = (xcd < r ? xcd * (q + 1) : r * (q + 1) + (xcd - r) * q) + off; }
        const int nig = WGM * nN, gid = wgid / nig, fm = gid * WGM, gsz = (nM - fm) < WGM ? (nM - fm) : WGM;
        u.pm = fm + ((wgid % nig) % gsz); u.pn = (wgid % nig) / gsz; return true;
    }
};

template <class Epi, class Sched>
__device__ __forceinline__ void gemm_phase(LAS unsigned char* lds, const Gemm g, const Sched& S, const Epi& E, int wv) {
    int tid = wv * 64 + lane_id(); asm volatile("" : "+v"(tid));
    const int wid = __builtin_amdgcn_readfirstlane(tid >> 6), lane = tid & 63, wr = wid >> 2, wc = wid & 3, fr = lane & 15, fq = lane >> 4;
    const int K = g.K, nt = K / BK, lda = g.lda;
    unsigned voffA[2], voffB[2];
#pragma unroll
    for (int i = 0; i < 2; ++i) { int R, C; stage_rc(tid * 16 + i * 8192, R, C); const int Rb = Epi::PERM ? ((R & ~31) + perm32(R & 31)) : R;
        voffA[i] = (unsigned)(R * lda + C) * 2u; voffB[i] = (unsigned)(Rb * K + C) * 2u; }
    const size_t kstep = (size_t)(BK * 2);
    const size_t hstepA = (size_t)HALF * lda * 2, hstepB = (size_t)HALF * K * 2;
    const size_t tstepA = 2 * hstepA, tstepB = 2 * hstepB;
    const unsigned ldsw = (unsigned)wid * 1024u;
    const int aoff = lds_byte(wr * 64 + fr, fq * 8), boff = lds_byte(wc * 32 + fr, fq * 8);
#define PG8_SA(b, h) (((b) * 2 + (h)) * HTB)
#define PG8_SB(b, h) ((4 + (b) * 2 + (h)) * HTB)
#define PG8_STAGE(bufoff, gbase, voff) do { _Pragma("unroll") for (int _i = 0; _i < 2; ++_i) \
        __builtin_amdgcn_global_load_lds((const unsigned*)((const char*)(gbase) + (voff)[_i]), (LAS unsigned*)(lds + (bufoff) + ldsw + _i * 8192), 16, 0, 0); } while (0)
#define PG8_LDA(dst, b, h) do { _Pragma("unroll") for (int m = 0; m < 4; ++m) _Pragma("unroll") for (int k = 0; k < 2; ++k) dst[m][k] = *(const LAS bf16x8*)(lds + PG8_SA(b, h) + aoff + m * 2048 + k * 1024); } while (0)
#define PG8_LDB(dst, b, h) do { _Pragma("unroll") for (int n = 0; n < 2; ++n) _Pragma("unroll") for (int k = 0; k < 2; ++k) dst[n][k] = *(const LAS bf16x8*)(lds + PG8_SB(b, h) + boff + n * 2048 + k * 1024); } while (0)
#define PG8_MMA(ai, bj, At, Bt) do { __builtin_amdgcn_s_setprio(1); _Pragma("unroll") for (int m = 0; m < 4; ++m) _Pragma("unroll") for (int n = 0; n < 2; ++n) _Pragma("unroll") for (int k = 0; k < 2; ++k) \
        acc[ai][bj][m][n] = __builtin_amdgcn_mfma_f32_16x16x32_bf16(Bt[n][k], At[m][k], acc[ai][bj][m][n], 0, 0, 0); __builtin_amdgcn_s_setprio(0); } while (0)
#define PG8_WAIT_V(n) asm volatile("s_waitcnt vmcnt(" #n ")" ::: "memory")
#define PG8_WAIT_L(n) asm volatile("s_waitcnt lgkmcnt(" #n ")" ::: "memory")
#define PG8_BAR __builtin_amdgcn_s_barrier()
#define PG8_SCHED __builtin_amdgcn_sched_barrier(0)
    Unit cur, nxt; int ui = 0;
    if (!S.next(0, cur)) return;
    f32x4 acc[2][2][4][2];
#pragma unroll
    for (int a = 0; a < 2; ++a)
#pragma unroll
        for (int b = 0; b < 2; ++b)
#pragma unroll
            for (int m = 0; m < 4; ++m)
#pragma unroll
                for (int n = 0; n < 2; ++n) acc[a][b][m][n] = (f32x4){0.f, 0.f, 0.f, 0.f};
    bf16x8 At[4][2], B0[2][2], B1[2][2];
    const char* cA = (const char*)g.A + (size_t)cur.pm * tstepA; const char* cB = (const char*)g.Bt + (size_t)cur.pn * tstepB;
    PG8_STAGE(PG8_SB(0, 0), cB, voffB); PG8_STAGE(PG8_SB(0, 1), cB + hstepB, voffB); PG8_STAGE(PG8_SA(0, 0), cA, voffA); PG8_STAGE(PG8_SA(0, 1), cA + hstepA, voffA);
    if (wr == 1) PG8_BAR;
    PG8_WAIT_V(2); PG8_BAR;
    PG8_STAGE(PG8_SB(1, 0), cB + kstep, voffB); PG8_STAGE(PG8_SA(1, 0), cA + kstep, voffA); PG8_STAGE(PG8_SB(1, 1), cB + hstepB + kstep, voffB);
    PG8_WAIT_V(6); PG8_BAR;
    for (;;) {
        const bool has_next = S.next(ui + 1, nxt);
        const char* nA = has_next ? (const char*)g.A + (size_t)nxt.pm * tstepA : cA; const char* nB = has_next ? (const char*)g.Bt + (size_t)nxt.pn * tstepB : cB;
        for (int t = 0; t < nt; t += 2) {
            const bool last = (t == nt - 2);
            const char* a1 = cA + (size_t)(t + 1) * kstep;
            const char* a2 = last ? nA : cA + (size_t)(t + 2) * kstep; const char* b2 = last ? nB : cB + (size_t)(t + 2) * kstep;
            const char* a3 = a2 + kstep; const char* b3 = b2 + kstep;
            PG8_LDB(B0, 0, 0); PG8_LDB(B1, 0, 1); PG8_SCHED; PG8_LDA(At, 0, 0); PG8_STAGE(PG8_SA(1, 1), a1 + hstepA, voffA);
            PG8_WAIT_V(8); PG8_WAIT_L(0); PG8_BAR; PG8_MMA(0, 0, At, B0); PG8_MMA(0, 1, At, B1); PG8_BAR; PG8_SCHED;
            PG8_LDA(At, 0, 1); PG8_STAGE(PG8_SB(0, 0), b2, voffB); PG8_STAGE(PG8_SB(0, 1), b2 + hstepB, voffB); PG8_STAGE(PG8_SA(0, 0), a2, voffA);
            PG8_WAIT_V(8); PG8_WAIT_L(0); PG8_BAR; PG8_MMA(1, 0, At, B0); PG8_MMA(1, 1, At, B1); PG8_BAR; PG8_SCHED;
            PG8_LDB(B0, 1, 0); PG8_LDB(B1, 1, 1); PG8_SCHED; PG8_LDA(At, 1, 0); PG8_STAGE(PG8_SA(0, 1), a2 + hstepA, voffA);
            PG8_WAIT_V(8); PG8_WAIT_L(0); PG8_BAR; PG8_MMA(0, 0, At, B0); PG8_MMA(0, 1, At, B1); PG8_BAR; PG8_SCHED;
            PG8_LDA(At, 1, 1); PG8_STAGE(PG8_SB(1, 0), b3, voffB); PG8_STAGE(PG8_SB(1, 1), b3 + hstepB, voffB); PG8_STAGE(PG8_SA(1, 0), a3, voffA);
            PG8_WAIT_V(8); PG8_WAIT_L(0); PG8_BAR; PG8_MMA(1, 0, At, B0); PG8_MMA(1, 1, At, B1); PG8_BAR; PG8_SCHED;
        }
        if (wr == 0) PG8_BAR;
        E(acc, cur, wr, wc, fr, fq);
        if (!has_next) break;
#pragma unroll
        for (int a = 0; a < 2; ++a)
#pragma unroll
            for (int b = 0; b < 2; ++b)
#pragma unroll
                for (int m = 0; m < 4; ++m)
#pragma unroll
                    for (int n = 0; n < 2; ++n) acc[a][b][m][n] = (f32x4){0.f, 0.f, 0.f, 0.f};
        cur = nxt; cA = nA; cB = nB; ++ui;
        if (wr == 1) PG8_BAR;
    }
    PG8_WAIT_V(0);
    PG8_BAR;
#undef PG8_SA
#undef PG8_SB
#undef PG8_STAGE
#undef PG8_LDA
#undef PG8_LDB
#undef PG8_MMA
#undef PG8_WAIT_V
#undef PG8_WAIT_L
#undef PG8_BAR
#undef PG8_SCHED
}
}

typedef const f32x4 (&AccRef)[2][2][4][2];
__device__ __forceinline__ u32x4 pack8(f32x4 v0, f32x4 v1) { u32x4 w; w.x = cvt_pk_bf16(v0[0], v0[1]); w.y = cvt_pk_bf16(v0[2], v0[3]); w.z = cvt_pk_bf16(v1[0], v1[1]); w.w = cvt_pk_bf16(v1[2], v1[3]); return w; }
__device__ __forceinline__ float sumsq4(f32x4 v) { return (v[0] * v[0] + v[1] * v[1]) + (v[2] * v[2] + v[3] * v[3]); }

struct EpiIn {
    static constexpr bool PERM = true;
    bf16_t* QKV; bf16_t* CQKV; bf16_t* KR; float* ssq_q; float* ssq_kv; const float* tda; const float* tmla;
    __device__ __forceinline__ void operator()(AccRef acc, const pg8::Unit& u, int wr, int wc, int fr, int fq) const {
        const int pn = u.pn, row0 = u.pm * 256 + wr * 64 + fr, cl = wc * 32 + 8 * fq;
        if (pn < 12) {
            const bool rope = (pn < 8) && ((wc & 1) == 0) && (fq < 2);
#pragma unroll
            for (int ai = 0; ai < 2; ++ai)
#pragma unroll
                for (int m = 0; m < 4; ++m) {
                    const int row = row0 + ai * 128 + m * 16; const int pos = row < S0 ? row : row - S0;
                    f32x4 cs = (f32x4){1.f, 1.f, 1.f, 1.f}, sn = (f32x4){0.f, 0.f, 0.f, 0.f};
                    if (rope) { cs = *(const f32x4*)(tda + (size_t)pos * 16 + 4 * fq); sn = *(const f32x4*)(tda + (size_t)pos * 16 + 8 + 4 * fq); }
#pragma unroll
                    for (int bj = 0; bj < 2; ++bj) {
                        const f32x4 v0 = acc[ai][bj][m][0], v1 = acc[ai][bj][m][1];
                        const f32x4 o0 = v0 * cs - v1 * sn, o1 = v1 * cs + v0 * sn;
                        const float qs = pn < 4 ? 0.125f * LOG2E : 1.0f;
                        *(u32x4*)(QKV + (size_t)row * 3072 + pn * 256 + bj * 128 + cl) = rope ? pack8(o0 * qs, o1 * qs) : pack8(v0 * qs, v1 * qs);
                    }
                }
        } else if (pn < 16) {
            float* ssq = pn < 14 ? ssq_q : ssq_kv;
#pragma unroll
            for (int ai = 0; ai < 2; ++ai)
#pragma unroll
                for (int m = 0; m < 4; ++m) {
                    const int row = row0 + ai * 128 + m * 16; float s = 0.f;
#pragma unroll
                    for (int bj = 0; bj < 2; ++bj) {
                        const f32x4 v0 = acc[ai][bj][m][0], v1 = acc[ai][bj][m][1];
                        s += sumsq4(v0) + sumsq4(v1);
                        *(u32x4*)(CQKV + (size_t)row * 1024 + (pn - 12) * 256 + bj * 128 + cl) = pack8(v0, v1);
                    }
                    s += shx<16>(s); s = add_halves(s);
                    if (fq == 0) ssq[(size_t)row * 8 + (pn & 1) * 4 + wc] = s;
                }
        } else {
            if (wc < 2) {
                const int g4 = 4 * (4 * wc + fq);
#pragma unroll
                for (int ai = 0; ai < 2; ++ai)
#pragma unroll
                    for (int m = 0; m < 4; ++m) {
                        const int row = row0 + ai * 128 + m * 16; const int pos = row < S0 ? row : row - S0;
                        const f32x4 cs = *(const f32x4*)(tmla + (size_t)pos * 64 + g4), sn = *(const f32x4*)(tmla + (size_t)pos * 64 + 32 + g4);
                        const f32x4 v0 = acc[ai][0][m][0], v1 = acc[ai][0][m][1];
                        const f32x4 o0 = v0 * cs - v1 * sn, o1 = v1 * cs + v0 * sn;
                        *(u32x4*)(KR + (size_t)row * 64 + cl) = pack8(o0, o1);
                    }
            }
        }
    }
};
struct EpiQb {
    static constexpr bool PERM = true;
    bf16_t* QM; const float* ssq_q; const float* tmla;
    __device__ __forceinline__ void operator()(AccRef acc, const pg8::Unit& u, int wr, int wc, int fr, int fq) const {
        const int pn = u.pn, row0 = u.pm * 256 + wr * 64 + fr, cl = wc * 32 + 8 * fq;
        const int g4 = 4 * (4 * (wc & 1) + fq);
        const bool rp0 = ((pn * 4 + 0 + (wc >> 1)) % 3) == 2, rp1 = ((pn * 4 + 2 + (wc >> 1)) % 3) == 2;
#pragma unroll
        for (int ai = 0; ai < 2; ++ai)
#pragma unroll
            for (int m = 0; m < 4; ++m) {
                const int row = row0 + ai * 128 + m * 16; const int pos = row < S0 ? row : row - S0;
                const f32x4 sa = *(const f32x4*)(ssq_q + (size_t)row * 8), sb = *(const f32x4*)(ssq_q + (size_t)row * 8 + 4);
                const float rs = rsqrtf((((sa[0] + sa[1]) + (sa[2] + sa[3])) + ((sb[0] + sb[1]) + (sb[2] + sb[3]))) * (1.0f / 512.0f) + EPS) * (0.07216878364870322f * LOG2E);
                f32x4 cs = (f32x4){1.f, 1.f, 1.f, 1.f}, sn = (f32x4){0.f, 0.f, 0.f, 0.f};
                if (rp0 || rp1) { cs = *(const f32x4*)(tmla + (size_t)pos * 64 + g4); sn = *(const f32x4*)(tmla + (size_t)pos * 64 + 32 + g4); }
#pragma unroll
                for (int bj = 0; bj < 2; ++bj) {
                    const bool rp = bj ? rp1 : rp0;
                    const f32x4 v0 = acc[ai][bj][m][0] * rs, v1 = acc[ai][bj][m][1] * rs;
                    const f32x4 o0 = v0 * cs - v1 * sn, o1 = v1 * cs + v0 * sn;
                    *(u32x4*)(QM + (size_t)row * 1536 + pn * 256 + bj * 128 + cl) = rp ? pack8(o0, o1) : pack8(v0, v1);
                }
            }
    }
};
struct EpiScale {
    static constexpr bool PERM = true;
    bf16_t* O; int ldo; const float* ssq; float inv_n;
    __device__ __forceinline__ void operator()(AccRef acc, const pg8::Unit& u, int wr, int wc, int fr, int fq) const {
        const int pn = u.pn, row0 = u.pm * 256 + wr * 64 + fr, cl = wc * 32 + 8 * fq;
#pragma unroll
        for (int ai = 0; ai < 2; ++ai)
#pragma unroll
            for (int m = 0; m < 4; ++m) {
                const int row = row0 + ai * 128 + m * 16;
                const f32x4 sa = *(const f32x4*)(ssq + (size_t)row * 8), sb = *(const f32x4*)(ssq + (size_t)row * 8 + 4);
                const float rs = rsqrtf((((sa[0] + sa[1]) + (sa[2] + sa[3])) + ((sb[0] + sb[1]) + (sb[2] + sb[3]))) * inv_n + EPS);
#pragma unroll
                for (int bj = 0; bj < 2; ++bj)
                    *(u32x4*)(O + (size_t)row * ldo + pn * 256 + bj * 128 + cl) = pack8(acc[ai][bj][m][0] * rs, acc[ai][bj][m][1] * rs);
            }
    }
};
__device__ __forceinline__ void unpack8(u32x4 w, f32x4& a, f32x4& b) { a = (f32x4){bf_lo(w.x), bf_hi(w.x), bf_lo(w.y), bf_hi(w.y)}; b = (f32x4){bf_lo(w.z), bf_hi(w.z), bf_lo(w.w), bf_hi(w.w)}; }
struct EpiPlain {
    static constexpr bool PERM = true;
    bf16_t* O; int ldo;
    __device__ __forceinline__ void operator()(AccRef acc, const pg8::Unit& u, int wr, int wc, int fr, int fq) const {
        const int pn = u.pn, row0 = u.pm * 256 + wr * 64 + fr, cl = wc * 32 + 8 * fq;
#pragma unroll
        for (int ai = 0; ai < 2; ++ai)
#pragma unroll
            for (int m = 0; m < 4; ++m) {
                const int row = row0 + ai * 128 + m * 16;
#pragma unroll
                for (int bj = 0; bj < 2; ++bj) *(u32x4*)(O + (size_t)row * ldo + pn * 256 + bj * 128 + cl) = pack8(acc[ai][bj][m][0], acc[ai][bj][m][1]);
            }
    }
};
template <int MODE> struct EpiGate {
    static constexpr bool PERM = true;
    bf16_t* MRG; const bf16_t* TMP;
    __device__ __forceinline__ void operator()(AccRef acc, const pg8::Unit& u, int wr, int wc, int fr, int fq) const {
        const int pn = u.pn, row0 = u.pm * 256 + wr * 64 + fr, cl = wc * 32 + 8 * fq;
#pragma unroll
        for (int ai = 0; ai < 2; ++ai)
#pragma unroll
            for (int m = 0; m < 4; ++m) {
                const int row = row0 + ai * 128 + m * 16;
#pragma unroll
                for (int bj = 0; bj < 2; ++bj) {
                    const size_t off = (size_t)row * 2048 + pn * 256 + bj * 128 + cl;
                    f32x4 g0 = acc[ai][bj][m][0], g1 = acc[ai][bj][m][1];
#pragma unroll
                    for (int e = 0; e < 4; ++e) { g0[e] = sigmoidf_(g0[e]); g1[e] = sigmoidf_(g1[e]); }
                    f32x4 m0, m1; unpack8(*(const u32x4*)(MRG + off), m0, m1);
                    if (MODE == 0) { m0 = m0 * g0; m1 = m1 * g1; }
                    else { f32x4 t0, t1; unpack8(*(const u32x4*)(TMP + off), t0, t1); m0 = m0 + g0 * t0; m1 = m1 + g1 * t1; }
                    *(u32x4*)(MRG + off) = pack8(m0, m1);
                }
            }
    }
};
struct EpiX1 {
    static constexpr bool PERM = true;
    const float* x0; const float* x1; bf16_t* XB;
    __device__ __forceinline__ void operator()(AccRef acc, const pg8::Unit& u, int wr, int wc, int fr, int fq) const {
        const int pn = u.pn, row0 = u.pm * 256 + wr * 64 + fr, cl = wc * 32 + 8 * fq;
#pragma unroll
        for (int ai = 0; ai < 2; ++ai)
#pragma unroll
            for (int m = 0; m < 4; ++m) {
                const int row = row0 + ai * 128 + m * 16;
                const float* xr = row < S0 ? x0 + (size_t)row * DM : x1 + (size_t)(row - S0) * DM;
#pragma unroll
                for (int bj = 0; bj < 2; ++bj) {
                    const int col = pn * 256 + bj * 128 + cl;
                    const f32x4 a0 = *(const f32x4*)(xr + col) + acc[ai][bj][m][0], a1 = *(const f32x4*)(xr + col + 4) + acc[ai][bj][m][1];
                    *(u32x4*)(XB + (size_t)row * DM + col) = pack8(a0, a1);
                }
            }
    }
};
struct EpiX2 {
    static constexpr bool PERM = true;
    bf16_t* XB;
    __device__ __forceinline__ void operator()(AccRef acc, const pg8::Unit& u, int wr, int wc, int fr, int fq) const {
        const int pn = u.pn, row0 = u.pm * 256 + wr * 64 + fr, cl = wc * 32 + 8 * fq;
#pragma unroll
        for (int ai = 0; ai < 2; ++ai)
#pragma unroll
            for (int m = 0; m < 4; ++m) {
                const int row = row0 + ai * 128 + m * 16;
#pragma unroll
                for (int bj = 0; bj < 2; ++bj) {
                    const size_t off = (size_t)row * DM + pn * 256 + bj * 128 + cl;
                    f32x4 m0, m1; unpack8(*(const u32x4*)(XB + off), m0, m1);
                    *(u32x4*)(XB + off) = pack8(m0 + acc[ai][bj][m][0], m1 + acc[ai][bj][m][1]);
                }
            }
    }
};
struct EpiSwiGLU {
    static constexpr bool PERM = true;
    bf16_t* ACT; const float* rstd;
    __device__ __forceinline__ void operator()(AccRef acc, const pg8::Unit& u, int wr, int wc, int fr, int fq) const {
        const int pn = u.pn, row0 = u.pm * 256 + wr * 64 + fr, cl = wc * 32 + 8 * fq;
#pragma unroll
        for (int ai = 0; ai < 2; ++ai)
#pragma unroll
            for (int m = 0; m < 4; ++m) {
                const int row = row0 + ai * 128 + m * 16;
                const float rs = rstd[row];
                f32x4 a[2];
#pragma unroll
                for (int n = 0; n < 2; ++n) { const f32x4 gt = acc[ai][0][m][n] * rs, up = acc[ai][1][m][n] * rs;
#pragma unroll
                    for (int e = 0; e < 4; ++e) a[n][e] = gt[e] * sigmoidf_(gt[e]) * up[e]; }
                *(u32x4*)(ACT + (size_t)row * FF + pn * 128 + cl) = pack8(a[0], a[1]);
            }
    }
};

namespace att {
constexpr int KVBLK = 64, SHM_V = 16384, SHM_K = 16384, SHM_KR = 8192;
#define KSWZ(row, colB) ((row) * 256 + ((colB) ^ (((row) & 15) << 4)))
#define KRSWZ(row, colB) ((row) * 128 + ((colB) ^ ((((row) >> 1) & 7) << 4)))
#define SBAR() __builtin_amdgcn_sched_barrier(0)
__device__ __forceinline__ int crow(int r, int hi) { return (r & 3) + 8 * (r >> 2) + 4 * hi; }
template <int MODE> struct Cst { static constexpr float SCALE = MODE ? 0.07216878364870322f : 0.125f; static constexpr float C = SCALE * LOG2E; static constexpr float THRS = 8.0f * LOG2E; };

template <int MODE> __device__ __forceinline__ void partialSM(f32x16& p0, f32x16& p1, float& m_reg, float& mn, float& alpha) {
    float pmax = p0[0];
#pragma unroll
    for (int r = 1; r < 16; ++r) pmax = fmaxf(pmax, p0[r]);
#pragma unroll
    for (int r = 0; r < 16; ++r) pmax = fmaxf(pmax, p1[r]);
    { auto rr = __builtin_amdgcn_permlane32_swap(__float_as_uint(pmax), __float_as_uint(pmax), false, false);
      pmax = fmaxf(__uint_as_float(rr[0]), __uint_as_float(rr[1])); }
    if (__builtin_expect(__all(pmax - m_reg <= Cst<MODE>::THRS), 1)) { mn = m_reg; alpha = 1.f; }
    else { mn = fmaxf(m_reg, pmax); alpha = __builtin_amdgcn_exp2f(m_reg - mn); m_reg = mn; }
#pragma unroll
    for (int r = 0; r < 16; ++r) p0[r] = p0[r] - mn;
#pragma unroll
    for (int r = 0; r < 16; ++r) p1[r] = p1[r] - mn;
#pragma unroll
    for (int r = 0; r < 16; ++r) p0[r] = __builtin_amdgcn_exp2f(p0[r]);
}
__device__ __forceinline__ void finishSM(f32x16& p0, f32x16& p1, float alpha, float& l_reg, bf16x8& pa0, bf16x8& pa1, bf16x8& pa2, bf16x8& pa3) {
#pragma unroll
    for (int r = 0; r < 16; ++r) p1[r] = __builtin_amdgcn_exp2f(p1[r]);
    typedef float f32x2 __attribute__((ext_vector_type(2)));
    f32x2 s2 = (f32x2){p0[0], p0[1]};
#pragma unroll
    for (int r = 2; r < 16; r += 2) s2 += (f32x2){p0[r], p0[r + 1]};
#pragma unroll
    for (int r = 0; r < 16; r += 2) s2 += (f32x2){p1[r], p1[r + 1]};
    float ps = s2.x + s2.y;
    { auto rr = __builtin_amdgcn_permlane32_swap(__float_as_uint(ps), __float_as_uint(ps), false, false);
      ps = __uint_as_float(rr[0]) + __uint_as_float(rr[1]); }
    l_reg = l_reg * alpha + ps;
#define PK4(P, BASE, OUT) do { unsigned a0 = cvt_pk_bf16(P[BASE + 0], P[BASE + 1]), a1 = cvt_pk_bf16(P[BASE + 2], P[BASE + 3]);   \
    unsigned b0 = cvt_pk_bf16(P[BASE + 4], P[BASE + 5]), b1 = cvt_pk_bf16(P[BASE + 6], P[BASE + 7]);                              \
    auto r0 = __builtin_amdgcn_permlane32_swap(a0, b0, false, false); auto r1 = __builtin_amdgcn_permlane32_swap(a1, b1, false, false); \
    u32x4 w = {r0[0], r1[0], r0[1], r1[1]}; OUT = *reinterpret_cast<bf16x8*>(&w); } while (0)
    PK4(p0, 0, pa0); PK4(p0, 8, pa1); PK4(p1, 0, pa2); PK4(p1, 8, pa3);
#undef PK4
}
template <int MODE> __device__ __forceinline__ void qkt(f32x16& p0, f32x16& p1, const LAS unsigned char* Kt, const LAS unsigned char* Krt, const bf16x8* qr, int r32, int hi, int comp) {
    p0 = f32x16{}; p1 = f32x16{};
    constexpr int NDN = MODE ? 8 : 4;
#pragma unroll
    for (int d0 = 0; d0 < NDN; ++d0) { const int cb = ((MODE ? 0 : comp * 64) + d0 * 16 + hi * 8) * 2;
        const bf16x8 b0 = *(const LAS bf16x8*)(Kt + KSWZ(r32, cb));
        const bf16x8 b1 = *(const LAS bf16x8*)(Kt + KSWZ(32 + r32, cb));
        p0 = __builtin_amdgcn_mfma_f32_32x32x16_bf16(b0, qr[d0], p0, 0, 0, 0);
        p1 = __builtin_amdgcn_mfma_f32_32x32x16_bf16(b1, qr[d0], p1, 0, 0, 0); }
    if constexpr (MODE == 1) {
#pragma unroll
        for (int d0 = 0; d0 < 4; ++d0) { const int cb = (d0 * 16 + hi * 8) * 2;
            const bf16x8 b0 = *(const LAS bf16x8*)(Krt + KRSWZ(r32, cb));
            const bf16x8 b1 = *(const LAS bf16x8*)(Krt + KRSWZ(32 + r32, cb));
            p0 = __builtin_amdgcn_mfma_f32_32x32x16_bf16(b0, qr[8 + d0], p0, 0, 0, 0);
            p1 = __builtin_amdgcn_mfma_f32_32x32x16_bf16(b1, qr[8 + d0], p1, 0, 0, 0); }
    }
}
__device__ __forceinline__ int v_st(int k, int c) { const int kk = (k & ~0xC) | ((k & 4) << 1) | ((k & 8) >> 1); return ((kk >> 3) * 4 + (c >> 5)) * 512 + ((kk & 7) * 32 + (c & 31)) * 2; }
__device__ __forceinline__ int v_rd_base(int lane) { return ((lane & 3) << 3) | (((lane >> 2) & 3) << 6) | (((lane >> 4) & 1) << 5) | (((lane >> 5) & 1) << 8); }
constexpr int v_rd_off(int d0, int ks, int half) { return d0 * 512 + ks * 4096 + half * 2048; }
template <int OFF> __device__ __forceinline__ s16x4 tr_read(int vb) {
    s16x4 r; asm volatile("ds_read_b64_tr_b16 %0, %1 offset:%2" : "=&v"(r) : "v"(vb), "i"(OFF) : "memory"); return r;
}
template <int D0> __device__ __forceinline__ void pv_one(f32x16& od, int vb, bf16x8 pa0, bf16x8 pa1, bf16x8 pa2, bf16x8 pa3) {
    const s16x4 l0 = tr_read<v_rd_off(D0, 0, 0)>(vb), h0 = tr_read<v_rd_off(D0, 0, 1)>(vb), l1 = tr_read<v_rd_off(D0, 1, 0)>(vb), h1 = tr_read<v_rd_off(D0, 1, 1)>(vb);
    const s16x4 l2 = tr_read<v_rd_off(D0, 2, 0)>(vb), h2 = tr_read<v_rd_off(D0, 2, 1)>(vb), l3 = tr_read<v_rd_off(D0, 3, 0)>(vb), h3 = tr_read<v_rd_off(D0, 3, 1)>(vb);
    asm volatile("s_waitcnt lgkmcnt(0)" ::: "memory"); SBAR();
#define PK(L, H) (bf16x8){L[0], L[1], L[2], L[3], H[0], H[1], H[2], H[3]}
    od = __builtin_amdgcn_mfma_f32_32x32x16_bf16(pa0, PK(l0, h0), od, 0, 0, 0);
    od = __builtin_amdgcn_mfma_f32_32x32x16_bf16(pa1, PK(l1, h1), od, 0, 0, 0);
    od = __builtin_amdgcn_mfma_f32_32x32x16_bf16(pa2, PK(l2, h2), od, 0, 0, 0);
    od = __builtin_amdgcn_mfma_f32_32x32x16_bf16(pa3, PK(l3, h3), od, 0, 0, 0);
#undef PK
}
__device__ __forceinline__ void pv_d0(f32x16* o, int vb, bf16x8 pa0, bf16x8 pa1, bf16x8 pa2, bf16x8 pa3) {
    pv_one<0>(o[0], vb, pa0, pa1, pa2, pa3); pv_one<1>(o[1], vb, pa0, pa1, pa2, pa3); pv_one<2>(o[2], vb, pa0, pa1, pa2, pa3); pv_one<3>(o[3], vb, pa0, pa1, pa2, pa3);
}
struct VFrag { s16x4 l0, h0, l1, h1, l2, h2, l3, h3; };
template <int D0> __device__ __forceinline__ void v_frag_read(VFrag& f, int vb) {
    f.l0 = tr_read<v_rd_off(D0, 0, 0)>(vb); f.h0 = tr_read<v_rd_off(D0, 0, 1)>(vb); f.l1 = tr_read<v_rd_off(D0, 1, 0)>(vb); f.h1 = tr_read<v_rd_off(D0, 1, 1)>(vb);
    f.l2 = tr_read<v_rd_off(D0, 2, 0)>(vb); f.h2 = tr_read<v_rd_off(D0, 2, 1)>(vb); f.l3 = tr_read<v_rd_off(D0, 3, 0)>(vb); f.h3 = tr_read<v_rd_off(D0, 3, 1)>(vb);
}
__device__ __forceinline__ void pv_mma(f32x16& od, const VFrag& f, bf16x8 pa0, bf16x8 pa1, bf16x8 pa2, bf16x8 pa3) {
#define PK(L, H) (bf16x8){L[0], L[1], L[2], L[3], H[0], H[1], H[2], H[3]}
    od = __builtin_amdgcn_mfma_f32_32x32x16_bf16(pa0, PK(f.l0, f.h0), od, 0, 0, 0);
    od = __builtin_amdgcn_mfma_f32_32x32x16_bf16(pa1, PK(f.l1, f.h1), od, 0, 0, 0);
    od = __builtin_amdgcn_mfma_f32_32x32x16_bf16(pa2, PK(f.l2, f.h2), od, 0, 0, 0);
    od = __builtin_amdgcn_mfma_f32_32x32x16_bf16(pa3, PK(f.l3, f.h3), od, 0, 0, 0);
#undef PK
}
#define LW(n) asm volatile("s_waitcnt lgkmcnt(" #n ")" ::: "memory")
template <int MODE, bool PF> __device__ __forceinline__ void pv_partial(f32x16* o, int vb, bf16x8 pa0, bf16x8 pa1, bf16x8 pa2, bf16x8 pa3, f32x16& p0, f32x16& p1, float& m_reg, float& alpha) {
    VFrag fa, fb;
    v_frag_read<0>(fa, vb);
    if constexpr (PF) { v_frag_read<1>(fb, vb); LW(8); } else LW(0);
    SBAR();
    pv_mma(o[0], fa, pa0, pa1, pa2, pa3);
    float pm0 = p0[0];
#pragma unroll
    for (int r = 1; r < 16; ++r) pm0 = fmaxf(pm0, p0[r]);
    if constexpr (PF) { v_frag_read<2>(fa, vb); LW(8); } else { v_frag_read<1>(fb, vb); LW(0); }
    SBAR();
    pv_mma(o[1], fb, pa0, pa1, pa2, pa3);
    float pmax = pm0;
#pragma unroll
    for (int r = 0; r < 16; ++r) pmax = fmaxf(pmax, p1[r]);
    { auto rr = __builtin_amdgcn_permlane32_swap(__float_as_uint(pmax), __float_as_uint(pmax), false, false);
      pmax = fmaxf(__uint_as_float(rr[0]), __uint_as_float(rr[1])); }
    const float mn = (pmax - m_reg > Cst<MODE>::THRS) ? fmaxf(m_reg, pmax) : m_reg;
    alpha = __builtin_amdgcn_exp2f(m_reg - mn); m_reg = mn;
    const f32x16 mnv = {mn, mn, mn, mn, mn, mn, mn, mn, mn, mn, mn, mn, mn, mn, mn, mn};
    if constexpr (PF) { v_frag_read<3>(fb, vb); LW(8); } else { v_frag_read<2>(fa, vb); LW(0); }
    SBAR();
    pv_mma(o[2], fa, pa0, pa1, pa2, pa3);
    p0 = p0 - mnv; p1 = p1 - mnv;
#pragma unroll
    for (int r = 0; r < 8; ++r) p0[r] = __builtin_amdgcn_exp2f(p0[r]);
    if constexpr (PF) { LW(0); } else { v_frag_read<3>(fb, vb); LW(0); }
    SBAR();
    pv_mma(o[3], fb, pa0, pa1, pa2, pa3);
#pragma unroll
    for (int r = 8; r < 16; ++r) p0[r] = __builtin_amdgcn_exp2f(p0[r]);
    asm volatile("" : "+v"(p0), "+v"(p1));
}
#undef LW
__device__ __forceinline__ bf16_t f2bf(float f) { return (bf16_t)(cvt_pk_bf16(f, f) & 0xffffu); }

template <int MODE, bool STORE = true>
__device__ __forceinline__ void attn_unit(LAS unsigned char* lds, const bf16_t* Qb, const bf16_t* __restrict__ Kh, const bf16_t* __restrict__ Krh, const bf16_t* __restrict__ Vh,
                                          int seq, bf16_t* Ob, float lam, const float* __restrict__ subg, int wv) {
    constexpr int ND = MODE ? 12 : 4, LDQ = MODE ? 1536 : 3072, LDK = MODE ? 2048 : 3072, LDO = MODE ? 1024 : 3072;
    constexpr bool PFV = (MODE == 0);
    constexpr int OFF_VR = 0, OFF_KRING = 3 * SHM_V, OFF_RRING = OFF_KRING + 2 * SHM_K, OFF_WS = OFF_RRING + (MODE ? 2 * SHM_KR : 0);
    int tid = wv * 64 + lane_id(); asm volatile("" : "+v"(tid));
    const int wid = __builtin_amdgcn_readfirstlane(tid >> 6), lane = tid & 63, r32 = lane & 31, hi = lane >> 5;
    const int comp = MODE ? 0 : (wid >> 2), wq = MODE ? wid : (wid & 3);
    LAS float* wsf = (LAS float*)(lds + OFF_WS) + wid * 64; LAS float* li_l = wsf; LAS float* al_l = wsf + 32;
    float m_reg = -1e30f, l_reg = 0; f32x16 o[4] = {}; bf16x8 qr[ND];
    const bf16_t* Qw = Qb + (size_t)(wq * 32 + r32) * LDQ + comp * 64 + hi * 8;
#pragma unroll
    for (int d0 = 0; d0 < ND; ++d0) qr[d0] = *(const bf16x8*)(Qw + d0 * 16);
    unsigned voffV[2], voffK[2];
#pragma unroll
    for (int i = 0; i < 2; ++i) {
        const int c = wid * 2 + i, ob = c * 1024 + lane * 16;
        { const int sub = ob >> 9, within = ob & 511, kk = (sub >> 2) * 8 + (within >> 6), k = (kk & ~0xC) | ((kk & 4) << 1) | ((kk & 8) >> 1), col = (sub & 3) * 32 + ((within & 63) >> 1);
          voffV[i] = (unsigned)(k * LDK + col) * 2u; }
        { const int row = 4 * c + (lane >> 4), g = lane & 15; voffK[i] = (unsigned)(row * LDK + ((g ^ (row & 15)) * 8)) * 2u; }
    }
    const int vb0 = (int)(unsigned)(uintptr_t)lds + v_rd_base(lane);
#define DMA_V(t, vo) do { const char* vt_ = (const char*)(Vh + (size_t)(t) * KVBLK * LDK); \
    _Pragma("unroll") for (int i_ = 0; i_ < 2; ++i_) \
        __builtin_amdgcn_global_load_lds((const unsigned*)(vt_ + voffV[0] + i_ * 128), (LAS unsigned*)(lds + OFF_VR + (vo) + (wid * 2 + i_) * 1024), 16, 0, 0); } while (0)
#define DMA_K(t, ki) do { const char* kt_ = (const char*)(Kh + (size_t)(t) * KVBLK * LDK); \
    _Pragma("unroll") for (int i_ = 0; i_ < 2; ++i_) \
        __builtin_amdgcn_global_load_lds((const unsigned*)(kt_ + voffK[i_]), (LAS unsigned*)(lds + OFF_KRING + (ki) * SHM_K + (wid * 2 + i_) * 1024), 16, 0, 0); \
    if constexpr (MODE == 1) { const int row_ = 8 * wid + (lane >> 3); const unsigned vr_ = (unsigned)(row_ * 64 + (((lane & 7) ^ ((row_ >> 1) & 7)) * 8)) * 2u;     \
        __builtin_amdgcn_global_load_lds((const unsigned*)((const char*)(Krh + (size_t)(t) * KVBLK * 64) + vr_), (LAS unsigned*)(lds + OFF_RRING + (ki) * SHM_KR + wid * 1024), 16, 0, 0); } } while (0)
#define RESC(a) do { if (__any((a) < 1.f)) { if (hi == 0) al_l[r32] = (a); asm volatile("s_waitcnt lgkmcnt(0)" ::: "memory"); \
    _Pragma("unroll") for (int d = 0; d < 4; ++d) _Pragma("unroll") for (int r = 0; r < 16; ++r) o[d][r] *= al_l[crow(r, hi)]; } } while (0)
#define KB(ki) (lds + OFF_KRING + (ki) * SHM_K)
#define KRB(ki) (lds + OFF_RRING + (ki) * SHM_KR)
#define LBAR() asm volatile("s_waitcnt vmcnt(0) lgkmcnt(0)\n\ts_barrier" ::: "memory")
#define ROT() do { k_cur ^= 1; const int t_ = v_pp; v_pp = v_p; v_p = v_c; v_c = t_; } while (0)
#define ITER(jj, PC0, PC1, alC, PP0, PP1, alP) do { \
    if (!g2) { if ((jj) + 1 < NT) DMA_K((jj) + 1, k_cur ^ 1); DMA_V((jj), v_c); } \
    SBAR(); qkt<MODE>(PC0, PC1, KB(k_cur), KRB(k_cur), qr, r32, hi, comp); \
    finishSM(PP0, PP1, alP, l_reg, pa0, pa1, pa2, pa3); SBAR(); \
    if (g2) LBAR(); \
    pv_partial<MODE, PFV>(o, vb0 + v_p, pa0, pa1, pa2, pa3, PC0, PC1, m_reg, alC); \
    RESC(alC); \
    if (g2) { if ((jj) + 2 < NT) DMA_K((jj) + 2, k_cur); if ((jj) + 1 < NT) DMA_V((jj) + 1, v_pp); } else LBAR(); \
    ROT(); } while (0)
    f32x16 pA0, pA1, pB0, pB1; float mnA, alA, alB; bf16x8 pa0, pa1, pa2, pa3; const int NT = seq / KVBLK;
    const bool g2 = wid >= 4;
    if (g2) __builtin_amdgcn_s_setprio(1);
    int k_cur = 0, v_pp = SHM_V, v_p = 2 * SHM_V, v_c = 0;
    DMA_K(0, 0); DMA_K(1, 1); DMA_V(0, 0); LBAR();
    qkt<MODE>(pA0, pA1, KB(0), KRB(0), qr, r32, hi, comp); partialSM<MODE>(pA0, pA1, m_reg, mnA, alA);
    if (g2) { LBAR(); DMA_K(2, 0); DMA_V(1, SHM_V); } else LBAR();
    ROT();
    int j = 1;
    for (; j + 2 < NT; j += 2) {
        ITER(j, pB0, pB1, alB, pA0, pA1, alA);
        ITER(j + 1, pA0, pA1, alA, pB0, pB1, alB);
    }
    ITER(j, pB0, pB1, alB, pA0, pA1, alA);
    finishSM(pB0, pB1, alB, l_reg, pa0, pa1, pa2, pa3); SBAR();
    pv_d0(o, vb0 + v_p, pa0, pa1, pa2, pa3);
    __builtin_amdgcn_s_setprio(0);
    if (hi == 0) li_l[r32] = l_reg; asm volatile("s_waitcnt lgkmcnt(0)" ::: "memory");
    float rli[16];
#pragma unroll
    for (int r = 0; r < 16; ++r) rli[r] = __builtin_amdgcn_rcpf(li_l[crow(r, hi)]);
    if constexpr (MODE == 1) {
        bf16_t* Ow = Ob + (size_t)(wq * 32) * LDO;
#pragma unroll
        for (int r = 0; r < 16; ++r) { const int orow = crow(r, hi);
#pragma unroll
            for (int d0 = 0; d0 < 4; ++d0) Ow[(size_t)orow * LDO + d0 * 32 + r32] = f2bf(o[d0][r] * rli[r]); }
        __syncthreads();
    } else {
        __syncthreads();
        LAS float* X = (LAS float*)lds + (size_t)wq * 4096 + lane;
        if (comp == 1) {
#pragma unroll
            for (int d0 = 0; d0 < 4; ++d0)
#pragma unroll
                for (int r = 0; r < 16; ++r) X[(d0 * 16 + r) * 64] = o[d0][r] * rli[r];
        }
        __syncthreads();
        if (comp == 0) {
            float ss[16];
#pragma unroll
            for (int r = 0; r < 16; ++r) { float s = 0.f;
#pragma unroll
                for (int d0 = 0; d0 < 4; ++d0) { const float v = o[d0][r] * rli[r] - lam * X[(d0 * 16 + r) * 64]; o[d0][r] = v; s += v * v; }
                ss[r] = s; }
#pragma unroll
            for (int r = 0; r < 16; ++r) { float s = ss[r];
                s += shx<1>(s); s += shx<2>(s); s += shx<4>(s); s += shx<8>(s); s += shx<16>(s);
                ss[r] = rsqrtf(s * (1.0f / 128.0f) + EPS) * 0.8f; }
            float gg[4];
#pragma unroll
            for (int d0 = 0; d0 < 4; ++d0) gg[d0] = subg[d0 * 32 + r32];
            bf16_t* Ow = Ob + (size_t)(wq * 32) * LDO;
#pragma unroll
            for (int r = 0; r < 16; ++r) { const int orow = crow(r, hi);
#pragma unroll
                for (int d0 = 0; d0 < 4; ++d0) { const bf16_t val = f2bf(o[d0][r] * ss[r] * gg[d0]); if (STORE || val == 0x7fc1) Ow[(size_t)orow * LDO + d0 * 32 + r32] = val; } }
        }
        __syncthreads();
    }
#undef DMA_V
#undef DMA_K
#undef RESC
#undef KB
#undef KRB
#undef LBAR
#undef ROT
#undef ITER
}
}

struct ColSrc { const float* p; int ld; };
template <class Map>
__device__ __forceinline__ void transpose_items(const Map mp, int K, int Nout, bf16_t* WT, const float* gain, LAS float* scr, int gw, int ngw, int lane) {
    const int nblk = Nout / 32, nitems = (K / 64) * nblk;
    for (int it = gw; it < nitems; it += ngw) {
        const int kb = it / nblk, nb = it % nblk, k0 = 64 * kb, n0 = 32 * nb;
        const ColSrc cs = mp(n0 + (lane & 31));
#pragma unroll 8
        for (int i = 0; i < 32; ++i) { const int kk = 2 * i + (lane >> 5);
            float v = cs.p ? cs.p[(size_t)(k0 + kk) * cs.ld] : 0.f; if (gain) v *= gain[k0 + kk];
            scr[kk * 33 + (lane & 31)] = v; }
        asm volatile("s_waitcnt lgkmcnt(0)" ::: "memory");
        const int c = lane & 7;
#pragma unroll
        for (int j = 0; j < 4; ++j) { const int n = (lane >> 3) + 8 * j; const LAS float* s = scr + (8 * c) * 33 + n;
            u32x4 o; o.x = cvt_pk_bf16(s[0 * 33], s[1 * 33]); o.y = cvt_pk_bf16(s[2 * 33], s[3 * 33]); o.z = cvt_pk_bf16(s[4 * 33], s[5 * 33]); o.w = cvt_pk_bf16(s[6 * 33], s[7 * 33]);
            *(u32x4*)(WT + (size_t)(n0 + n) * K + k0 + 8 * c) = o; }
        asm volatile("s_waitcnt lgkmcnt(0)" ::: "memory");
    }
}
__device__ __forceinline__ int rope_src(int j, int ng) { const int g = j >> 3; if (g >= ng) return j; return ((j & 7) < 4 ? 0 : 4 * ng) + 4 * g + (j & 3); }
struct MapIn { const float* w;
    __device__ ColSrc operator()(int n) const {
        int src;
        if (n < 2048) src = (n & ~63) + rope_src(n & 63, 2);
        else if (n < 4096) src = n;
        else if (n < 4160) src = 4096 + rope_src(n - 4096, 8);
        else return ColSrc{nullptr, 0};
        return ColSrc{w + src, 8256}; } };
struct MapG { const float* w;
    __device__ ColSrc operator()(int n) const { return ColSrc{w + 4160 + n, 8256}; } };
struct MapQb { const float* w;
    __device__ ColSrc operator()(int n) const { const int blk = n >> 6; const int src = (blk % 3 == 2) ? (n & ~63) + rope_src(n & 63, 8) : n; return ColSrc{w + src, 1536}; } };
struct MapId { const float* w; int ld;
    __device__ ColSrc operator()(int n) const { return ColSrc{w + n, ld}; } };
struct MapGu { const float* wg; const float* wu;
    __device__ ColSrc operator()(int n) const { const int t = n >> 8, r = n & 255; return r < 128 ? ColSrc{wg + t * 128 + r, FF} : ColSrc{wu + t * 128 + (r - 128), FF}; } };

struct Args {
    const float* in[21]; float* out; unsigned char* ws;
};
constexpr int NWAVES = 8;
constexpr int LDS_BYTES = 147456;

__global__ void __launch_bounds__(NWAVES * 64, 2) fwd_mega(Args a) {
    extern __shared__ __attribute__((aligned(16))) unsigned char lds_raw[];
    LAS unsigned char* lds = (LAS unsigned char*)lds_raw;
    cg::grid_group grid = cg::this_grid();
    const int G = gridDim.x, bx = blockIdx.x;
    const int wv = __builtin_amdgcn_readfirstlane((int)threadIdx.x >> 6);
    volatile LAS unsigned* bst = (volatile LAS unsigned*)(lds + 139264);
    if (threadIdx.x < 2) bst[threadIdx.x] = 0u;
    const int vcu = (G % 8 == 0) ? (bx % 8) * (G / 8) + bx / 8 : bx;
#define PHASE_PTRS() \
    size_t zoff_ = 0; asm volatile("" : "+s"(zoff_)); unsigned char* ws = a.ws + zoff_; \
    int tid = wv * 64 + lane_id(); asm volatile("" : "+v"(tid)); const int lane = tid & 63, wave = wv; (void)lane; (void)wave; \
    const int gw = vcu * NWAVES + wave, ngw = G * NWAVES; (void)gw; (void)ngw; \
    const float* x0 = a.in[0]; const float* x1 = a.in[1]; (void)x0; (void)x1; \
    float* ssq_q = (float*)(ws + WS_SSQ); float* ssq_kv = (float*)(ws + WS_SSQ + MiB); float* rstd1 = (float*)(ws + WS_RSTD); (void)ssq_q; (void)ssq_kv; (void)rstd1; \
    float* tda = (float*)(ws + WS_TDA); float* tmla = (float*)(ws + WS_TMLA); (void)tda; (void)tmla; \
    bf16_t* Wi = (bf16_t*)(ws + WS_WI); bf16_t* Wg = (bf16_t*)(ws + WS_WG); bf16_t* Wqb = (bf16_t*)(ws + WS_WQB); bf16_t* Wkvb = (bf16_t*)(ws + WS_WKVB); bf16_t* Wbda = (bf16_t*)(ws + WS_WBDA); \
    bf16_t* Wbmla = (bf16_t*)(ws + WS_WBMLA); bf16_t* Wout = (bf16_t*)(ws + WS_WOUT); bf16_t* Wgu = (bf16_t*)(ws + WS_WGU); bf16_t* Wd = (bf16_t*)(ws + WS_WD); \
    bf16_t* QKV = (bf16_t*)(ws + WS_QKV); bf16_t* TMP = QKV; bf16_t* X1B = QKV; bf16_t* CQKV = (bf16_t*)(ws + WS_CQKV); bf16_t* OM = CQKV; bf16_t* KR = (bf16_t*)(ws + WS_KR); \
    bf16_t* XN = (bf16_t*)(ws + WS_XN); bf16_t* KVM = (bf16_t*)(ws + WS_KVM); bf16_t* MRG = KVM; bf16_t* QM = (bf16_t*)(ws + WS_QM); bf16_t* ACT = (bf16_t*)(ws + WS_ACT); \
    (void)Wi; (void)Wg; (void)Wqb; (void)Wkvb; (void)Wbda; (void)Wbmla; (void)Wout; (void)Wgu; (void)Wd; (void)QKV; (void)TMP; (void)X1B; (void)CQKV; (void)OM; (void)KR; (void)XN; (void)KVM; (void)MRG; (void)QM; (void)ACT;
#define GRID_BAR() xcd_barrier((unsigned*)(a.ws + WS_BAR), bst, wv == 0 && lane_id() == 0)

    {
        PHASE_PTRS();
        LAS float* scr = (LAS float*)(lds + wave * 16384);
        if (bx == 0) for (int i = tid; i < XCD_BAR_WORDS; i += 512) ((unsigned*)(ws + WS_BAR))[i] = 0u;
        for (int i = bx * 512 + tid; i < S1 * 40; i += G * 512) {
            const int pos = i / 40, k = i % 40;
            const float expo = k < 8 ? (float)k * (1.0f / 8.0f) : (float)(k - 8) * (1.0f / 32.0f);
            const float inv = __builtin_amdgcn_exp2f(-expo * 18.931568569324174f);
            const float ang = (float)pos * inv;
            const double rev = (double)ang * 0.15915494309189535; const float fr = (float)(rev - __builtin_rint(rev));
            const float c = __builtin_amdgcn_cosf(fr), sn = __builtin_amdgcn_sinf(fr);
            if (k < 8) { tda[(size_t)pos * 16 + k] = c; tda[(size_t)pos * 16 + 8 + k] = sn; }
            else { tmla[(size_t)pos * 64 + (k - 8)] = c; tmla[(size_t)pos * 64 + 32 + (k - 8)] = sn; }
        }
        transpose_items(MapIn{a.in[3]}, 2048, NINP, Wi, nullptr, scr, gw, ngw, lane);
        transpose_items(MapG{a.in[3]}, 2048, 4096, Wg, nullptr, scr, gw, ngw, lane);
        transpose_items(MapQb{a.in[10]}, 512, 1536, Wqb, a.in[9], scr, gw, ngw, lane);
        transpose_items(MapId{a.in[12], 2048}, 512, 2048, Wkvb, a.in[11], scr, gw, ngw, lane);
        transpose_items(MapId{a.in[13], 2048}, 1024, 2048, Wbda, nullptr, scr, gw, ngw, lane);
        transpose_items(MapId{a.in[14], 2048}, 1024, 2048, Wbmla, nullptr, scr, gw, ngw, lane);
        const float* gn = a.in[2];
        for (int m = gw; m < T; m += ngw) {
            const float* xr = m < S0 ? x0 + (size_t)m * DM : x1 + (size_t)(m - S0) * DM;
            f32x4 v[8]; float sq = 0.f;
#pragma unroll
            for (int j = 0; j < 8; ++j) { v[j] = *(const f32x4*)(xr + j * 256 + lane * 4); sq += sumsq4(v[j]); }
            const float rs = rsqrtf(wave_sum(sq) * (1.0f / DM) + EPS);
#pragma unroll
            for (int j = 0; j < 8; ++j) { const f32x4 gv = *(const f32x4*)(gn + j * 256 + lane * 4); const f32x4 y = v[j] * rs * gv;
                u32x2 w; w.x = cvt_pk_bf16(y[0], y[1]); w.y = cvt_pk_bf16(y[2], y[3]); *(u32x2*)(XN + (size_t)m * DM + j * 256 + lane * 4) = w; }
        }
    }
    grid.sync();
    if (wv == 0 && lane_id() == 0) (void)xb_add(&((unsigned*)(a.ws + WS_BAR))[XB_XCNT(xb_xcc_id())], 1u);
    {
        PHASE_PTRS();
        pg8::Gemm g{XN, Wi, T, NINP, 2048, 2048}; pg8::StaticOrder S; S.init(T, NINP, G, bx);
        EpiIn E{QKV, CQKV, KR, ssq_q, ssq_kv, tda, tmla};
        pg8::gemm_phase(lds, g, S, E, wv);
    }
    GRID_BAR();
    {
        PHASE_PTRS();
        pg8::Gemm g{CQKV, Wqb, T, 1536, 512, 1024}; pg8::StaticOrder S; S.init(T, 1536, G, bx);
        EpiQb E{QM, ssq_q, tmla};
        pg8::gemm_phase(lds, g, S, E, wv);
    }
    {
        PHASE_PTRS();
        pg8::Gemm g{CQKV + 512, Wkvb, T, 2048, 512, 1024}; pg8::StaticOrder S; S.init(T, 2048, G, bx);
        EpiScale E{KVM, 2048, ssq_kv, 1.0f / 512.0f};
        pg8::gemm_phase(lds, g, S, E, wv);
    }
    GRID_BAR();
    {
        PHASE_PTRS();
        float lam;
        { const float a1 = a.in[4][lane] * a.in[5][lane], a2 = a.in[6][lane] * a.in[7][lane];
          lam = __builtin_amdgcn_exp2f(wave_sum(a1) * LOG2E) - __builtin_amdgcn_exp2f(wave_sum(a2) * LOG2E) + 0.2f; }
        const float* subg = a.in[8];
#ifdef PROBE_DA2
        for (int u = vcu; u < 1024 + 512; u += G) {
            const bool smp = u < 1024; const int uu = smp ? u : u - 1024;
            const int h = (uu & 255) >> 5, qb = (uu >> 8) * 32 + (uu & 31);
            const int seq0 = smp ? S0 : 0, seq = smp ? S1 : S0;
            const bf16_t* base = QKV + (size_t)seq0 * 3072 + h * 128;
            bf16_t* qp = QKV + (size_t)(seq0 + qb * 128) * 3072 + h * 128;
            att::attn_unit<0, false>(lds, qp, base + 1024, nullptr, base + 2048, seq, qp, lam, subg, wv);
        }
#endif
        for (int u = vcu; u < 1024 + 512; u += G) {
            const bool smp = u < 1024; const int uu = smp ? u : u - 1024;
            const int h = (uu & 255) >> 5, qb = (uu >> 8) * 32 + (uu & 31);
            const int seq0 = smp ? S0 : 0, seq = smp ? S1 : S0;
            const bf16_t* base = QKV + (size_t)seq0 * 3072 + h * 128;
            bf16_t* qp = QKV + (size_t)(seq0 + qb * 128) * 3072 + h * 128;
            att::attn_unit<0>(lds, qp, base + 1024, nullptr, base + 2048, seq, qp, lam, subg, wv);
        }
#ifdef PROBE_MLA2
        for (int rep_ = 0; rep_ < 2; ++rep_)
#endif
        for (int u = vcu; u < 512 + 256; u += G) {
            const bool smp = u < 512; const int uu = smp ? u : u - 512;
            const int h = (uu & 255) >> 5, qb = (uu >> 8) * 32 + (uu & 31);
            const int seq0 = smp ? S0 : 0, seq = smp ? S1 : S0;
            const bf16_t* qp = QM + (size_t)(seq0 + qb * 256) * 1536 + h * 192;
            const bf16_t* kp = KVM + (size_t)seq0 * 2048 + h * 256;
            att::attn_unit<1>(lds, qp, kp, KR + (size_t)seq0 * 64, kp + 128, seq, OM + (size_t)(seq0 + qb * 256) * 1024 + h * 128, 0.f, nullptr, wv);
        }
    }
    GRID_BAR();
    {
        PHASE_PTRS();
        LAS float* scr = (LAS float*)(lds + wave * 16384);
        transpose_items(MapId{a.in[15], 2048}, 2048, 2048, Wout, nullptr, scr, gw, ngw, lane);
        __syncthreads();
    }
    {
        PHASE_PTRS();
        pg8::Gemm g{QKV, Wbda, T, 2048, 1024, 3072}; pg8::StaticOrder S; S.init(T, 2048, G, bx);
        EpiPlain E{MRG, 2048};
        pg8::gemm_phase(lds, g, S, E, wv);
    }
    {
        PHASE_PTRS();
        pg8::Gemm g{XN, Wg, T, 2048, 2048, 2048}; pg8::StaticOrder S; S.init(T, 2048, G, bx);
        EpiGate<0> E{MRG, nullptr};
        pg8::gemm_phase(lds, g, S, E, wv);
    }
    GRID_BAR();
    {
        PHASE_PTRS();
        pg8::Gemm g{OM, Wbmla, T, 2048, 1024, 1024}; pg8::StaticOrder S; S.init(T, 2048, G, bx);
        EpiPlain E{TMP, 2048};
        pg8::gemm_phase(lds, g, S, E, wv);
    }
    {
        PHASE_PTRS();
        pg8::Gemm g{XN, Wg + (size_t)2048 * 2048, T, 2048, 2048, 2048}; pg8::StaticOrder S; S.init(T, 2048, G, bx);
        EpiGate<1> E{MRG, TMP};
        pg8::gemm_phase(lds, g, S, E, wv);
    }
    GRID_BAR();
    {
        PHASE_PTRS();
        pg8::Gemm g{MRG, Wout, T, 2048, 2048, 2048}; pg8::StaticOrder S; S.init(T, 2048, G, bx);
        EpiX1 E{x0, x1, X1B};
        pg8::gemm_phase(lds, g, S, E, wv);
    }
    GRID_BAR();
    {
        PHASE_PTRS();
        LAS float* scr = (LAS float*)(lds + wave * 16384);
        transpose_items(MapGu{a.in[17], a.in[18]}, 2048, 11264, Wgu, a.in[16], scr, gw, ngw, lane);
        transpose_items(MapId{a.in[19], 2048}, FF, 2048, Wd, nullptr, scr, gw, ngw, lane);
        for (int m = gw; m < T; m += ngw) {
            float sq = 0.f;
#pragma unroll
            for (int j = 0; j < 4; ++j) { f32x4 p, q; unpack8(*(const u32x4*)(X1B + (size_t)m * DM + j * 512 + lane * 8), p, q); sq += sumsq4(p) + sumsq4(q); }
            sq = wave_sum(sq);
            if (lane == 0) rstd1[m] = rsqrtf(sq * (1.0f / DM) + EPS);
        }
        __syncthreads();
    }
    GRID_BAR();
    {
        PHASE_PTRS();
        pg8::Gemm g{X1B, Wgu, T, 11264, 2048, 2048}; pg8::StaticOrder S; S.init(T, 11264, G, bx);
        EpiSwiGLU E{ACT, rstd1};
        pg8::gemm_phase(lds, g, S, E, wv);
    }
    GRID_BAR();
    {
        PHASE_PTRS();
        pg8::Gemm g{ACT, Wd, T, 2048, FF, FF}; pg8::StaticOrder S; S.init(T, 2048, G, bx);
        EpiX2 E{X1B};
        pg8::gemm_phase(lds, g, S, E, wv);
    }
    GRID_BAR();
    {
        PHASE_PTRS();
        const float* gn = a.in[20];
        for (int m = gw; m < T; m += ngw) {
            f32x4 v[8]; float sq = 0.f;
#pragma unroll
            for (int j = 0; j < 4; ++j) { unpack8(*(const u32x4*)(X1B + (size_t)m * DM + j * 512 + lane * 8), v[2 * j], v[2 * j + 1]); sq += sumsq4(v[2 * j]) + sumsq4(v[2 * j + 1]); }
            const float rs = rsqrtf(wave_sum(sq) * (1.0f / DM) + EPS);
            float* orow = a.out + (size_t)m * DM;
#pragma unroll
            for (int j = 0; j < 4; ++j) { const int c = j * 512 + lane * 8;
                *(f32x4*)(orow + c) = v[2 * j] * rs * *(const f32x4*)(gn + c); *(f32x4*)(orow + c + 4) = v[2 * j + 1] * rs * *(const f32x4*)(gn + c + 4); }
        }
    }
}

extern "C" void kernel_launch(void* const* d_in, const int* in_sizes, int n_in, void* d_out, int out_size, void* d_ws, size_t ws_size, hipStream_t stream) {
    static int grid = 0;
    if (grid == 0) {
        if (n_in != 21 || in_sizes[0] != S0 * DM || in_sizes[1] != S1 * DM || out_size != T * DM || ws_size < WS_END) {
            fprintf(stderr, "kernel_launch: shape mismatch n_in %d in0 %d in1 %d out %d ws %zu (need %zu)\n", n_in, n_in > 0 ? in_sizes[0] : -1, n_in > 1 ? in_sizes[1] : -1, out_size, ws_size, (size_t)WS_END);
            grid = -1; return; }
        int dev = 0, cus = 0, per_cu = 0;
        if (hipGetDevice(&dev) != hipSuccess || hipDeviceGetAttribute(&cus, hipDeviceAttributeMultiprocessorCount, dev) != hipSuccess) { grid = -1; return; }
        if (hipFuncSetAttribute((const void*)fwd_mega, hipFuncAttributeMaxDynamicSharedMemorySize, LDS_BYTES) != hipSuccess) { fprintf(stderr, "kernel_launch: hipFuncSetAttribute failed\n"); grid = -1; return; }
        if (hipOccupancyMaxActiveBlocksPerMultiprocessor(&per_cu, (const void*)fwd_mega, NWAVES * 64, LDS_BYTES) != hipSuccess || per_cu < 1) { fprintf(stderr, "kernel_launch: occupancy query says %d\n", per_cu); per_cu = 1; }
        (void)hipGetLastError();
        grid = cus * per_cu;
    }
    if (grid < 0) return;
    Args a{};
    for (int i = 0; i < 21; ++i) a.in[i] = (const float*)d_in[i];
    a.out = (float*)d_out; a.ws = (unsigned char*)d_ws;
    void* args[] = {&a};
    const hipError_t e = hipLaunchCooperativeKernel((void*)fwd_mega, dim3(grid), dim3(NWAVES * 64), args, LDS_BYTES, stream);
    if (e != hipSuccess) fprintf(stderr, "kernel_launch: cooperative launch failed: %s (grid %d)\n", hipGetErrorString(e), grid);
}
```

```cpp
#include <hip/hip_runtime.h>
#include <hip/hip_cooperative_groups.h>
#include <cstdio>
#include <cstdint>
namespace cg = cooperative_groups;

#define LAS __attribute__((address_space(3)))
typedef unsigned short bf16_t;
typedef short bf16x8 __attribute__((ext_vector_type(8)));
typedef short s16x4 __attribute__((ext_vector_type(4)));
typedef float f32x4 __attribute__((ext_vector_type(4)));
typedef float f32x16 __attribute__((ext_vector_type(16)));
typedef unsigned u32x4 __attribute__((ext_vector_type(4)));
typedef unsigned u32x2 __attribute__((ext_vector_type(2)));

constexpr int DM = 2048, S0 = 8192, S1 = 16384, T = S0 + S1;
constexpr int FF = 5632;
constexpr float EPS = 1e-6f;
constexpr float LOG2E = 1.4426950408889634f;

constexpr size_t MiB = 1u << 20;
constexpr size_t WS_SSQ = 0;
constexpr size_t WS_BAR = 2 * MiB;
constexpr size_t WS_RSTD = 2 * MiB + 256 * 1024;
constexpr size_t WS_TDA = 3 * MiB;
constexpr size_t WS_TMLA = 4 * MiB;
constexpr size_t WS_WI = 8 * MiB;
constexpr size_t WS_WG = 25 * MiB;
constexpr size_t WS_WQB = 41 * MiB;
constexpr size_t WS_WKVB = WS_WQB + 3 * MiB / 2;
constexpr size_t WS_WBDA = WS_WKVB + 2 * MiB;
constexpr size_t WS_WBMLA = WS_WBDA + 4 * MiB;
constexpr size_t WS_QKV = 53 * MiB;
constexpr size_t WS_CQKV = 197 * MiB;
constexpr size_t WS_KR = 245 * MiB;
constexpr size_t WS_XN = 248 * MiB;
constexpr size_t WS_KVM = 344 * MiB;
constexpr size_t WS_QM = 440 * MiB;
constexpr size_t WS_WOUT = 440 * MiB;
constexpr size_t WS_ACT = 149 * MiB;
constexpr size_t WS_WGU = 413 * MiB;
constexpr size_t WS_WD = 457 * MiB;
constexpr size_t WS_END = 512 * MiB;
constexpr int NINP = 4352;

__device__ __forceinline__ unsigned cvt_pk_bf16(float lo, float hi) { unsigned r; asm volatile("v_cvt_pk_bf16_f32 %0, %1, %2" : "=v"(r) : "v"(lo), "v"(hi)); return r; }
__device__ __forceinline__ float bf_lo(unsigned u) { return __uint_as_float(u << 16); }
__device__ __forceinline__ float bf_hi(unsigned u) { return __uint_as_float(u & 0xffff0000u); }
template <int K> __device__ __forceinline__ float shx(float v) {
    return __int_as_float(__builtin_amdgcn_ds_swizzle(__float_as_int(v), (K << 10) | 0x1f));
}
__device__ __forceinline__ float add_halves(float v) { auto rr = __builtin_amdgcn_permlane32_swap(__float_as_uint(v), __float_as_uint(v), false, false); return __uint_as_float(rr[0]) + __uint_as_float(rr[1]); }
__device__ __forceinline__ float wave_sum(float v) {
    v += shx<1>(v); v += shx<2>(v); v += shx<4>(v); v += shx<8>(v); v += shx<16>(v);
    return add_halves(v);
}
__device__ __forceinline__ float sigmoidf_(float x) { return __builtin_amdgcn_rcpf(1.0f + __builtin_amdgcn_exp2f(-x * LOG2E)); }
__device__ __forceinline__ void atomic_addf(float* p, float v) { __hip_atomic_fetch_add(p, v, __ATOMIC_RELAXED, __HIP_MEMORY_SCOPE_AGENT); }

__device__ __forceinline__ int lane_id() { return (int)__builtin_amdgcn_mbcnt_hi(~0u, __builtin_amdgcn_mbcnt_lo(~0u, 0u)); }
#define XB_TMO      128
#define XB_XCNT(j)  (256  + 64 * (j))
#define XB_XSUB(j)  (1280 + 64 * (j))
#define XB_XGEN(j)  (2304 + 64 * (j))
#define XB_TOP      3328
#define XB_TOPGEN   3392
#define XCD_BAR_WORDS 3456
#define XB_SPIN_CAP (1u << 22)
__device__ __forceinline__ unsigned xb_ld(unsigned* p)              { return __hip_atomic_load(p, __ATOMIC_RELAXED, __HIP_MEMORY_SCOPE_AGENT); }
__device__ __forceinline__ unsigned xb_add(unsigned* p, unsigned v) { return __hip_atomic_fetch_add(p, v, __ATOMIC_RELAXED, __HIP_MEMORY_SCOPE_AGENT); }
__device__ __forceinline__ unsigned xb_xcc_id() { return (unsigned)__builtin_amdgcn_s_getreg((3 << 11) | 20) & 0xFu; }
#define XB_SPIN(cond, bar) do { unsigned _sp = 0; while (cond) { __builtin_amdgcn_s_sleep(1); \
    if ((++_sp & 255u) == 0u) { if (xb_ld(&(bar)[XB_TMO])) break; if (_sp > XB_SPIN_CAP) { atomicAdd(&(bar)[XB_TMO], 1u); break; } } } } while (0)
__device__ __forceinline__ void xcd_barrier_complete(unsigned* bar, unsigned x, unsigned G, unsigned& nloc, unsigned& nx) {
    unsigned sum, cnt, mine, sp = 0u;
    for (;;) {
        sum = 0u; cnt = 0u; mine = 0u;
#pragma unroll
        for (unsigned j = 0; j < 16; ++j) { const unsigned c = xb_ld(&bar[XB_XCNT(j)]); sum += c; cnt += (c > 0u) ? 1u : 0u; mine = (j == x) ? c : mine; }
        if (sum == G) break;
        __builtin_amdgcn_s_sleep(1);
        if ((++sp & 255u) == 0u) { if (xb_ld(&bar[XB_TMO])) break; if (sp > XB_SPIN_CAP) { atomicAdd(&bar[XB_TMO], 1u); break; } }
    }
    nloc = mine > 0u ? mine : 1u; nx = cnt > 0u ? cnt : 1u;
}
__device__ __forceinline__ void xcd_barrier(unsigned* bar, volatile LAS unsigned* st, bool leader) {
    asm volatile("s_waitcnt vmcnt(0)" ::: "memory");
    __syncthreads();
    if (leader) {
        __builtin_amdgcn_s_waitcnt(0);
        const unsigned x = xb_xcc_id();
        unsigned nloc = st[0], nx = st[1];
        if (nloc == 0u) { xcd_barrier_complete(bar, x, gridDim.x, nloc, nx); st[0] = nloc; st[1] = nx; }
        const unsigned old = xb_add(&bar[XB_XSUB(x)], 1u);
        const unsigned gen = old / nloc;
        if (old + 1u == (gen + 1u) * nloc) {
            __builtin_amdgcn_fence(__ATOMIC_RELEASE, "agent");
            asm volatile("s_waitcnt vmcnt(0)" ::: "memory");
            const unsigned og = xb_add(&bar[XB_TOP], 1u);
            const unsigned tg = og / nx;
            if (og + 1u == (tg + 1u) * nx) xb_add(&bar[XB_TOPGEN], 1u);
            else XB_SPIN(xb_ld(&bar[XB_TOPGEN]) == tg, bar);
            __builtin_amdgcn_fence(__ATOMIC_ACQUIRE, "agent");
            xb_add(&bar[XB_XGEN(x)], 1u);
            asm volatile("s_waitcnt vmcnt(0)" ::: "memory");
        } else {
            XB_SPIN(xb_ld(&bar[XB_XGEN(x)]) == gen, bar);
            __builtin_amdgcn_fence(__ATOMIC_ACQUIRE, "agent");
            asm volatile("s_waitcnt vmcnt(0)" ::: "memory");
        }
    }
    __syncthreads();
}

namespace pg8 {
constexpr int BM = 256, BK = 64, HALF = 128, HTB = HALF * BK * 2, STAGE_BYTES = 8 * HTB, NXCD = 8, WGM = 8;
__host__ __device__ __forceinline__ int lds_byte(int r, int c) { const int st = (r >> 4) * 2 + (c >> 5), rr = r & 15, cc = c & 31, ob = rr * 64 + cc * 2; return st * 1024 + (ob ^ (((ob >> 9) & 1) << 5)); }
__host__ __device__ __forceinline__ void stage_rc(int b, int& R, int& C) { const int st = b / 1024, sb = b % 1024, swz = sb ^ (((sb >> 9) & 1) << 5); R = (st >> 1) * 16 + swz / 64; C = (st & 1) * 32 + (swz % 64) / 2; }
__host__ __device__ __forceinline__ int perm32(int rho) { const int n = rho >> 4, i = rho & 15; return 8 * (i >> 2) + 4 * n + (i & 3); }

struct Unit { int pm, pn; };
struct Gemm { const bf16_t* A; const bf16_t* Bt; int M, N, K, lda; };
struct StaticOrder {
    int nM, nN, nwg, G, c;
    __device__ void init(int M, int N, int G_, int c_) { nM = M / BM; nN = N / BM; nwg = nM * nN; G = G_; c = c_; }
    __device__ bool next(int i, Unit& u) const {
        const long L = (long)i * G + c; if (L >= nwg) return false;
        int wgid = (int)L; { const int q = nwg / NXCD, r = nwg % NXCD, xcd = wgid % NXCD, off = wgid / NXCD; wgid = (xcd < r ? xcd * (q + 1) : r * (q + 1) + (xcd - r) * q) + off; }
        const int nig = WGM * nN, gid = wgid / nig, fm = gid * WGM, gsz = (nM - fm) < WGM ? (nM - fm) : WGM;
        u.pm = fm + ((wgid % nig) % gsz); u.pn = (wgid % nig) / gsz; return true;
    }
};

template <class Epi, class Sched>
__device__ __forceinline__ void gemm_phase(LAS unsigned char* lds, const Gemm g, const Sched& S, const Epi& E, int wv) {
    int tid = wv * 64 + lane_id(); asm volatile("" : "+v"(tid));
    const int wid = __builtin_amdgcn_readfirstlane(tid >> 6), lane = tid & 63, wr = wid >> 2, wc = wid & 3, fr = lane & 15, fq = lane >> 4;
    const int K = g.K, nt = K / BK, lda = g.lda;
    unsigned voffA[2], voffB[2];
#pragma unroll
    for (int i = 0; i < 2; ++i) { int R, C; stage_rc(tid * 16 + i * 8192, R, C); const int Rb = Epi::PERM ? ((R & ~31) + perm32(R & 31)) : R;
        voffA[i] = (unsigned)(R * lda + C) * 2u; voffB[i] = (unsigned)(Rb * K + C) * 2u; }
    const size_t kstep = (size_t)(BK * 2);
    const size_t hstepA = (size_t)HALF * lda * 2, hstepB = (size_t)HALF * K * 2;
    const size_t tstepA = 2 * hstepA, tstepB = 2 * hstepB;
    const unsigned ldsw = (unsigned)wid * 1024u;
    const int aoff = lds_byte(wr * 64 + fr, fq * 8), boff = lds_byte(wc * 32 + fr, fq * 8);
#define PG8_SA(b, h) (((b) * 2 + (h)) * HTB)
#define PG8_SB(b, h) ((4 + (b) * 2 + (h)) * HTB)
#define PG8_STAGE(bufoff, gbase, voff) do { _Pragma("unroll") for (int _i = 0; _i < 2; ++_i) \
        __builtin_amdgcn_global_load_lds((const unsigned*)((const char*)(gbase) + (voff)[_i]), (LAS unsigned*)(lds + (bufoff) + ldsw + _i * 8192), 16, 0, 0); } while (0)
#define PG8_LDA(dst, b, h) do { _Pragma("unroll") for (int m = 0; m < 4; ++m) _Pragma("unroll") for (int k = 0; k < 2; ++k) dst[m][k] = *(const LAS bf16x8*)(lds + PG8_SA(b, h) + aoff + m * 2048 + k * 1024); } while (0)
#define PG8_LDB(dst, b, h) do { _Pragma("unroll") for (int n = 0; n < 2; ++n) _Pragma("unroll") for (int k = 0; k < 2; ++k) dst[n][k] = *(const LAS bf16x8*)(lds + PG8_SB(b, h) + boff + n * 2048 + k * 1024); } while (0)
#define PG8_MMA(ai, bj, At, Bt) do { __builtin_amdgcn_s_setprio(1); _Pragma("unroll") for (int m = 0; m < 4; ++m) _Pragma("unroll") for (int n = 0; n < 2; ++n) _Pragma("unroll") for (int k = 0; k < 2; ++k) \
        acc[ai][bj][m][n] = __builtin_amdgcn_mfma_f32_16x16x32_bf16(Bt[n][k], At[m][k], acc[ai][bj][m][n], 0, 0, 0); __builtin_amdgcn_s_setprio(0); } while (0)
#define PG8_WAIT_V(n) asm volatile("s_waitcnt vmcnt(" #n ")" ::: "memory")
#define PG8_WAIT_L(n) asm volatile("s_waitcnt lgkmcnt(" #n ")" ::: "memory")
#define PG8_BAR __builtin_amdgcn_s_barrier()
#define PG8_SCHED __builtin_amdgcn_sched_barrier(0)
    Unit cur, nxt; int ui = 0;
    if (!S.next(0, cur)) return;
    f32x4 acc[2][2][4][2];
#pragma unroll
    for (int a = 0; a < 2; ++a)
#pragma unroll
        for (int b = 0; b < 2; ++b)
#pragma unroll
            for (int m = 0; m < 4; ++m)
#pragma unroll
                for (int n = 0; n < 2; ++n) acc[a][b][m][n] = (f32x4){0.f, 0.f, 0.f, 0.f};
    bf16x8 At[4][2], B0[2][2], B1[2][2];
    const char* cA = (const char*)g.A + (size_t)cur.pm * tstepA; const char* cB = (const char*)g.Bt + (size_t)cur.pn * tstepB;
    PG8_STAGE(PG8_SB(0, 0), cB, voffB); PG8_STAGE(PG8_SB(0, 1), cB + hstepB, voffB); PG8_STAGE(PG8_SA(0, 0), cA, voffA); PG8_STAGE(PG8_SA(0, 1), cA + hstepA, voffA);
    if (wr == 1) PG8_BAR;
    PG8_WAIT_V(2); PG8_BAR;
    PG8_STAGE(PG8_SB(1, 0), cB + kstep, voffB); PG8_STAGE(PG8_SA(1, 0), cA + kstep, voffA); PG8_STAGE(PG8_SB(1, 1), cB + hstepB + kstep, voffB);
    PG8_WAIT_V(6); PG8_BAR;
    for (;;) {
        const bool has_next = S.next(ui + 1, nxt);
        const char* nA = has_next ? (const char*)g.A + (size_t)nxt.pm * tstepA : cA; const char* nB = has_next ? (const char*)g.Bt + (size_t)nxt.pn * tstepB : cB;
        for (int t = 0; t < nt; t += 2) {
            const bool last = (t == nt - 2);
            const char* a1 = cA + (size_t)(t + 1) * kstep;
            const char* a2 = last ? nA : cA + (size_t)(t + 2) * kstep; const char* b2 = last ? nB : cB + (size_t)(t + 2) * kstep;
            const char* a3 = a2 + kstep; const char* b3 = b2 + kstep;
            PG8_LDB(B0, 0, 0); PG8_LDB(B1, 0, 1); PG8_SCHED; PG8_LDA(At, 0, 0); PG8_STAGE(PG8_SA(1, 1), a1 + hstepA, voffA);
            PG8_WAIT_V(8); PG8_WAIT_L(0); PG8_BAR; PG8_MMA(0, 0, At, B0); PG8_MMA(0, 1, At, B1); PG8_BAR; PG8_SCHED;
            PG8_LDA(At, 0, 1); PG8_STAGE(PG8_SB(0, 0), b2, voffB); PG8_STAGE(PG8_SB(0, 1), b2 + hstepB, voffB); PG8_STAGE(PG8_SA(0, 0), a2, voffA);
            PG8_WAIT_V(8); PG8_WAIT_L(0); PG8_BAR; PG8_MMA(1, 0, At, B0); PG8_MMA(1, 1, At, B1); PG8_BAR; PG8_SCHED;
            PG8_LDB(B0, 1, 0); PG8_LDB(B1, 1, 1); PG8_SCHED; PG8_LDA(At, 1, 0); PG8_STAGE(PG8_SA(0, 1), a2 + hstepA, voffA);
            PG8_WAIT_V(8); PG8_WAIT_L(0); PG8_BAR; PG8_MMA(0, 0, At, B0); PG8_MMA(0, 1, At, B1); PG8_BAR; PG8_SCHED;
            PG8_LDA(At, 1, 1); PG8_STAGE(PG8_SB(1, 0), b3, voffB); PG8_STAGE(PG8_SB(1, 1), b3 + hstepB, voffB); PG8_STAGE(PG8_SA(1, 0), a3, voffA);
            PG8_WAIT_V(8); PG8_WAIT_L(0); PG8_BAR; PG8_MMA(1, 0, At, B0); PG8_MMA(1, 1, At, B1); PG8_BAR; PG8_SCHED;
        }
        if (wr == 0) PG8_BAR;
        E(acc, cur, wr, wc, fr, fq);
        if (!has_next) break;
#pragma unroll
        for (int a = 0; a < 2; ++a)
#pragma unroll
            for (int b = 0; b < 2; ++b)
#pragma unroll
                for (int m = 0; m < 4; ++m)
#pragma unroll
                    for (int n = 0; n < 2; ++n) acc[a][b][m][n] = (f32x4){0.f, 0.f, 0.f, 0.f};
        cur = nxt; cA = nA; cB = nB; ++ui;
        if (wr == 1) PG8_BAR;
    }
    PG8_WAIT_V(0);
    PG8_BAR;
#undef PG8_SA
#undef PG8_SB
#undef PG8_STAGE
#undef PG8_LDA
#undef PG8_LDB
#undef PG8_MMA
#undef PG8_WAIT_V
#undef PG8_WAIT_L
#undef PG8_BAR
#undef PG8_SCHED
}
}

typedef const f32x4 (&AccRef)[2][2][4][2];
__device__ __forceinline__ u32x4 pack8(f32x4 v0, f32x4 v1) { u32x4 w; w.x = cvt_pk_bf16(v0[0], v0[1]); w.y = cvt_pk_bf16(v0[2], v0[3]); w.z = cvt_pk_bf16(v1[0], v1[1]); w.w = cvt_pk_bf16(v1[2], v1[3]); return w; }
__device__ __forceinline__ float sumsq4(f32x4 v) { return (v[0] * v[0] + v[1] * v[1]) + (v[2] * v[2] + v[3] * v[3]); }

struct EpiIn {
    static constexpr bool PERM = true;
    bf16_t* QKV; bf16_t* CQKV; bf16_t* KR; float* ssq_q; float* ssq_kv; const float* tda; const float* tmla;
    __device__ __forceinline__ void operator()(AccRef acc, const pg8::Unit& u, int wr, int wc, int fr, int fq) const {
        const int pn = u.pn, row0 = u.pm * 256 + wr * 64 + fr, cl = wc * 32 + 8 * fq;
        if (pn < 12) {
            const bool rope = (pn < 8) && ((wc & 1) == 0) && (fq < 2);
#pragma unroll
            for (int ai = 0; ai < 2; ++ai)
#pragma unroll
                for (int m = 0; m < 4; ++m) {
                    const int row = row0 + ai * 128 + m * 16; const int pos = row < S0 ? row : row - S0;
                    f32x4 cs = (f32x4){1.f, 1.f, 1.f, 1.f}, sn = (f32x4){0.f, 0.f, 0.f, 0.f};
                    if (rope) { cs = *(const f32x4*)(tda + (size_t)pos * 16 + 4 * fq); sn = *(const f32x4*)(tda + (size_t)pos * 16 + 8 + 4 * fq); }
#pragma unroll
                    for (int bj = 0; bj < 2; ++bj) {
                        const f32x4 v0 = acc[ai][bj][m][0], v1 = acc[ai][bj][m][1];
                        const f32x4 o0 = v0 * cs - v1 * sn, o1 = v1 * cs + v0 * sn;
                        const float qs = pn < 4 ? 0.125f * LOG2E : 1.0f;
                        *(u32x4*)(QKV + (size_t)row * 3072 + pn * 256 + bj * 128 + cl) = rope ? pack8(o0 * qs, o1 * qs) : pack8(v0 * qs, v1 * qs);
                    }
                }
        } else if (pn < 16) {
            float* ssq = pn < 14 ? ssq_q : ssq_kv;
#pragma unroll
            for (int ai = 0; ai < 2; ++ai)
#pragma unroll
                for (int m = 0; m < 4; ++m) {
                    const int row = row0 + ai * 128 + m * 16; float s = 0.f;
#pragma unroll
                    for (int bj = 0; bj < 2; ++bj) {
                        const f32x4 v0 = acc[ai][bj][m][0], v1 = acc[ai][bj][m][1];
                        s += sumsq4(v0) + sumsq4(v1);
                        *(u32x4*)(CQKV + (size_t)row * 1024 + (pn - 12) * 256 + bj * 128 + cl) = pack8(v0, v1);
                    }
                    s += shx<16>(s); s = add_halves(s);
                    if (fq == 0) ssq[(size_t)row * 8 + (pn & 1) * 4 + wc] = s;
                }
        } else {
            if (wc < 2) {
                const int g4 = 4 * (4 * wc + fq);
#pragma unroll
                for (int ai = 0; ai < 2; ++ai)
#pragma unroll
                    for (int m = 0; m < 4; ++m) {
                        const int row = row0 + ai * 128 + m * 16; const int pos = row < S0 ? row : row - S0;
                        const f32x4 cs = *(const f32x4*)(tmla + (size_t)pos * 64 + g4), sn = *(const f32x4*)(tmla + (size_t)pos * 64 + 32 + g4);
                        const f32x4 v0 = acc[ai][0][m][0], v1 = acc[ai][0][m][1];
                        const f32x4 o0 = v0 * cs - v1 * sn, o1 = v1 * cs + v0 * sn;
                        *(u32x4*)(KR + (size_t)row * 64 + cl) = pack8(o0, o1);
                    }
            }
        }
    }
};
struct EpiQb {
    static constexpr bool PERM = true;
    bf16_t* QM; const float* ssq_q; const float* tmla;
    __device__ __forceinline__ void operator()(AccRef acc, const pg8::Unit& u, int wr, int wc, int fr, int fq) const {
        const int pn = u.pn, row0 = u.pm * 256 + wr * 64 + fr, cl = wc * 32 + 8 * fq;
        const int g4 = 4 * (4 * (wc & 1) + fq);
        const bool rp0 = ((pn * 4 + 0 + (wc >> 1)) % 3) == 2, rp1 = ((pn * 4 + 2 + (wc >> 1)) % 3) == 2;
#pragma unroll
        for (int ai = 0; ai < 2; ++ai)
#pragma unroll
            for (int m = 0; m < 4; ++m) {
                const int row = row0 + ai * 128 + m * 16; const int pos = row < S0 ? row : row - S0;
                const f32x4 sa = *(const f32x4*)(ssq_q + (size_t)row * 8), sb = *(const f32x4*)(ssq_q + (size_t)row * 8 + 4);
                const float rs = rsqrtf((((sa[0] + sa[1]) + (sa[2] + sa[3])) + ((sb[0] + sb[1]) + (sb[2] + sb[3]))) * (1.0f / 512.0f) + EPS) * (0.07216878364870322f * LOG2E);
                f32x4 cs = (f32x4){1.f, 1.f, 1.f, 1.f}, sn = (f32x4){0.f, 0.f, 0.f, 0.f};
                if (rp0 || rp1) { cs = *(const f32x4*)(tmla + (size_t)pos * 64 + g4); sn = *(const f32x4*)(tmla + (size_t)pos * 64 + 32 + g4); }
#pragma unroll
                for (int bj = 0; bj < 2; ++bj) {
                    const bool rp = bj ? rp1 : rp0;
                    const f32x4 v0 = acc[ai][bj][m][0] * rs, v1 = acc[ai][bj][m][1] * rs;
                    const f32x4 o0 = v0 * cs - v1 * sn, o1 = v1 * cs + v0 * sn;
                    *(u32x4*)(QM + (size_t)row * 1536 + pn * 256 + bj * 128 + cl) = rp ? pack8(o0, o1) : pack8(v0, v1);
                }
            }
    }
};
struct EpiScale {
    static constexpr bool PERM = true;
    bf16_t* O; int ldo; const float* ssq; float inv_n;
    __device__ __forceinline__ void operator()(AccRef acc, const pg8::Unit& u, int wr, int wc, int fr, int fq) const {
        const int pn = u.pn, row0 = u.pm * 256 + wr * 64 + fr, cl = wc * 32 + 8 * fq;
#pragma unroll
        for (int ai = 0; ai < 2; ++ai)
#pragma unroll
            for (int m = 0; m < 4; ++m) {
                const int row = row0 + ai * 128 + m * 16;
                const f32x4 sa = *(const f32x4*)(ssq + (size_t)row * 8), sb = *(const f32x4*)(ssq + (size_t)row * 8 + 4);
                const float rs = rsqrtf((((sa[0] + sa[1]) + (sa[2] + sa[3])) + ((sb[0] + sb[1]) + (sb[2] + sb[3]))) * inv_n + EPS);
#pragma unroll
                for (int bj = 0; bj < 2; ++bj)
                    *(u32x4*)(O + (size_t)row * ldo + pn * 256 + bj * 128 + cl) = pack8(acc[ai][bj][m][0] * rs, acc[ai][bj][m][1] * rs);
            }
    }
};
__device__ __forceinline__ void unpack8(u32x4 w, f32x4& a, f32x4& b) { a = (f32x4){bf_lo(w.x), bf_hi(w.x), bf_lo(w.y), bf_hi(w.y)}; b = (f32x4){bf_lo(w.z), bf_hi(w.z), bf_lo(w.w), bf_hi(w.w)}; }
struct EpiPlain {
    static constexpr bool PERM = true;
    bf16_t* O; int ldo;
    __device__ __forceinline__ void operator()(AccRef acc, const pg8::Unit& u, int wr, int wc, int fr, int fq) const {
        const int pn = u.pn, row0 = u.pm * 256 + wr * 64 + fr, cl = wc * 32 + 8 * fq;
#pragma unroll
        for (int ai = 0; ai < 2; ++ai)
#pragma unroll
            for (int m = 0; m < 4; ++m) {
                const int row = row0 + ai * 128 + m * 16;
#pragma unroll
                for (int bj = 0; bj < 2; ++bj) *(u32x4*)(O + (size_t)row * ldo + pn * 256 + bj * 128 + cl) = pack8(acc[ai][bj][m][0], acc[ai][bj][m][1]);
            }
    }
};
template <int MODE> struct EpiGate {
    static constexpr bool PERM = true;
    bf16_t* MRG; const bf16_t* TMP;
    __device__ __forceinline__ void operator()(AccRef acc, const pg8::Unit& u, int wr, int wc, int fr, int fq) const {
        const int pn = u.pn, row0 = u.pm * 256 + wr * 64 + fr, cl = wc * 32 + 8 * fq;
#pragma unroll
        for (int ai = 0; ai < 2; ++ai)
#pragma unroll
            for (int m = 0; m < 4; ++m) {
                const int row = row0 + ai * 128 + m * 16;
#pragma unroll
                for (int bj = 0; bj < 2; ++bj) {
                    const size_t off = (size_t)row * 2048 + pn * 256 + bj * 128 + cl;
                    f32x4 g0 = acc[ai][bj][m][0], g1 = acc[ai][bj][m][1];
#pragma unroll
                    for (int e = 0; e < 4; ++e) { g0[e] = sigmoidf_(g0[e]); g1[e] = sigmoidf_(g1[e]); }
                    f32x4 m0, m1; unpack8(*(const u32x4*)(MRG + off), m0, m1);
                    if (MODE == 0) { m0 = m0 * g0; m1 = m1 * g1; }
                    else { f32x4 t0, t1; unpack8(*(const u32x4*)(TMP + off), t0, t1); m0 = m0 + g0 * t0; m1 = m1 + g1 * t1; }
                    *(u32x4*)(MRG + off) = pack8(m0, m1);
                }
            }
    }
};
struct EpiX1 {
    static constexpr bool PERM = true;
    const float* x0; const float* x1; bf16_t* XB;
    __device__ __forceinline__ void operator()(AccRef acc, const pg8::Unit& u, int wr, int wc, int fr, int fq) const {
        const int pn = u.pn, row0 = u.pm * 256 + wr * 64 + fr, cl = wc * 32 + 8 * fq;
#pragma unroll
        for (int ai = 0; ai < 2; ++ai)
#pragma unroll
            for (int m = 0; m < 4; ++m) {
                const int row = row0 + ai * 128 + m * 16;
                const float* xr = row < S0 ? x0 + (size_t)row * DM : x1 + (size_t)(row - S0) * DM;
#pragma unroll
                for (int bj = 0; bj < 2; ++bj) {
                    const int col = pn * 256 + bj * 128 + cl;
                    const f32x4 a0 = *(const f32x4*)(xr + col) + acc[ai][bj][m][0], a1 = *(const f32x4*)(xr + col + 4) + acc[ai][bj][m][1];
                    *(u32x4*)(XB + (size_t)row * DM + col) = pack8(a0, a1);
                }
            }
    }
};
struct EpiX2 {
    static constexpr bool PERM = true;
    bf16_t* XB;
    __device__ __forceinline__ void operator()(AccRef acc, const pg8::Unit& u, int wr, int wc, int fr, int fq) const {
        const int pn = u.pn, row0 = u.pm * 256 + wr * 64 + fr, cl = wc * 32 + 8 * fq;
#pragma unroll
        for (int ai = 0; ai < 2; ++ai)
#pragma unroll
            for (int m = 0; m < 4; ++m) {
                const int row = row0 + ai * 128 + m * 16;
#pragma unroll
                for (int bj = 0; bj < 2; ++bj) {
                    const size_t off = (size_t)row * DM + pn * 256 + bj * 128 + cl;
                    f32x4 m0, m1; unpack8(*(const u32x4*)(XB + off), m0, m1);
                    *(u32x4*)(XB + off) = pack8(m0 + acc[ai][bj][m][0], m1 + acc[ai][bj][m][1]);
                }
            }
    }
};
struct EpiSwiGLU {
    static constexpr bool PERM = true;
    bf16_t* ACT; const float* rstd;
    __device__ __forceinline__ void operator()(AccRef acc, const pg8::Unit& u, int wr, int wc, int fr, int fq) const {
        const int pn = u.pn, row0 = u.pm * 256 + wr * 64 + fr, cl = wc * 32 + 8 * fq;
#pragma unroll
        for (int ai = 0; ai < 2; ++ai)
#pragma unroll
            for (int m = 0; m < 4; ++m) {
                const int row = row0 + ai * 128 + m * 16;
                const float rs = rstd[row];
                f32x4 a[2];
#pragma unroll
                for (int n = 0; n < 2; ++n) { const f32x4 gt = acc[ai][0][m][n] * rs, up = acc[ai][1][m][n] * rs;
#pragma unroll
                    for (int e = 0; e < 4; ++e) a[n][e] = gt[e] * sigmoidf_(gt[e]) * up[e]; }
                *(u32x4*)(ACT + (size_t)row * FF + pn * 128 + cl) = pack8(a[0], a[1]);
            }
    }
};

namespace att {
constexpr int KVBLK = 64, SHM_V = 16384, SHM_K = 16384, SHM_KR = 8192;
#define KSWZ(row, colB) ((row) * 256 + ((colB) ^ (((row) & 15) << 4)))
#define KRSWZ(row, colB) ((row) * 128 + ((colB) ^ ((((row) >> 1) & 7) << 4)))
#define SBAR() __builtin_amdgcn_sched_barrier(0)
__device__ __forceinline__ int crow(int r, int hi) { return (r & 3) + 8 * (r >> 2) + 4 * hi; }
template <int MODE> struct Cst { static constexpr float SCALE = MODE ? 0.07216878364870322f : 0.125f; static constexpr float C = SCALE * LOG2E; static constexpr float THRS = 8.0f * LOG2E; };

template <int MODE> __device__ __forceinline__ void partialSM(f32x16& p0, f32x16& p1, float& m_reg, float& mn, float& alpha) {
    float pmax = p0[0];
#pragma unroll
    for (int r = 1; r < 16; ++r) pmax = fmaxf(pmax, p0[r]);
#pragma unroll
    for (int r = 0; r < 16; ++r) pmax = fmaxf(pmax, p1[r]);
    { auto rr = __builtin_amdgcn_permlane32_swap(__float_as_uint(pmax), __float_as_uint(pmax), false, false);
      pmax = fmaxf(__uint_as_float(rr[0]), __uint_as_float(rr[1])); }
    if (__builtin_expect(__all(pmax - m_reg <= Cst<MODE>::THRS), 1)) { mn = m_reg; alpha = 1.f; }
    else { mn = fmaxf(m_reg, pmax); alpha = __builtin_amdgcn_exp2f(m_reg - mn); m_reg = mn; }
#pragma unroll
    for (int r = 0; r < 16; ++r) p0[r] = p0[r] - mn;
#pragma unroll
    for (int r = 0; r < 16; ++r) p1[r] = p1[r] - mn;
#pragma unroll
    for (int r = 0; r < 16; ++r) p0[r] = __builtin_amdgcn_exp2f(p0[r]);
}
__device__ __forceinline__ void finishSM(f32x16& p0, f32x16& p1, float alpha, float& l_reg, bf16x8& pa0, bf16x8& pa1, bf16x8& pa2, bf16x8& pa3) {
#pragma unroll
    for (int r = 0; r < 16; ++r) p1[r] = __builtin_amdgcn_exp2f(p1[r]);
    typedef float f32x2 __attribute__((ext_vector_type(2)));
    f32x2 s2 = (f32x2){p0[0], p0[1]};
#pragma unroll
    for (int r = 2; r < 16; r += 2) s2 += (f32x2){p0[r], p0[r + 1]};
#pragma unroll
    for (int r = 0; r < 16; r += 2) s2 += (f32x2){p1[r], p1[r + 1]};
    float ps = s2.x + s2.y;
    { auto rr = __builtin_amdgcn_permlane32_swap(__float_as_uint(ps), __float_as_uint(ps), false, false);
      ps = __uint_as_float(rr[0]) + __uint_as_float(rr[1]); }
    l_reg = l_reg * alpha + ps;
#define PK4(P, BASE, OUT) do { unsigned a0 = cvt_pk_bf16(P[BASE + 0], P[BASE + 1]), a1 = cvt_pk_bf16(P[BASE + 2], P[BASE + 3]);   \
    unsigned b0 = cvt_pk_bf16(P[BASE + 4], P[BASE + 5]), b1 = cvt_pk_bf16(P[BASE + 6], P[BASE + 7]);                              \
    auto r0 = __builtin_amdgcn_permlane32_swap(a0, b0, false, false); auto r1 = __builtin_amdgcn_permlane32_swap(a1, b1, false, false); \
    u32x4 w = {r0[0], r1[0], r0[1], r1[1]}; OUT = *reinterpret_cast<bf16x8*>(&w); } while (0)
    PK4(p0, 0, pa0); PK4(p0, 8, pa1); PK4(p1, 0, pa2); PK4(p1, 8, pa3);
#undef PK4
}
template <int MODE> __device__ __forceinline__ void qkt(f32x16& p0, f32x16& p1, const LAS unsigned char* Kt, const LAS unsigned char* Krt, const bf16x8* qr, int r32, int hi, int comp) {
    p0 = f32x16{}; p1 = f32x16{};
    constexpr int NDN = MODE ? 8 : 4;
#pragma unroll
    for (int d0 = 0; d0 < NDN; ++d0) { const int cb = ((MODE ? 0 : comp * 64) + d0 * 16 + hi * 8) * 2;
        const bf16x8 b0 = *(const LAS bf16x8*)(Kt + KSWZ(r32, cb));
        const bf16x8 b1 = *(const LAS bf16x8*)(Kt + KSWZ(32 + r32, cb));
        p0 = __builtin_amdgcn_mfma_f32_32x32x16_bf16(b0, qr[d0], p0, 0, 0, 0);
        p1 = __builtin_amdgcn_mfma_f32_32x32x16_bf16(b1, qr[d0], p1, 0, 0, 0); }
    if constexpr (MODE == 1) {
#pragma unroll
        for (int d0 = 0; d0 < 4; ++d0) { const int cb = (d0 * 16 + hi * 8) * 2;
            const bf16x8 b0 = *(const LAS bf16x8*)(Krt + KRSWZ(r32, cb));
            const bf16x8 b1 = *(const LAS bf16x8*)(Krt + KRSWZ(32 + r32, cb));
            p0 = __builtin_amdgcn_mfma_f32_32x32x16_bf16(b0, qr[8 + d0], p0, 0, 0, 0);
            p1 = __builtin_amdgcn_mfma_f32_32x32x16_bf16(b1, qr[8 + d0], p1, 0, 0, 0); }
    }
}
__device__ __forceinline__ int v_st(int k, int c) { const int kk = (k & ~0xC) | ((k & 4) << 1) | ((k & 8) >> 1); return ((kk >> 3) * 4 + (c >> 5)) * 512 + ((kk & 7) * 32 + (c & 31)) * 2; }
__device__ __forceinline__ int v_rd_base(int lane) { return ((lane & 3) << 3) | (((lane >> 2) & 3) << 6) | (((lane >> 4) & 1) << 5) | (((lane >> 5) & 1) << 8); }
constexpr int v_rd_off(int d0, int ks, int half) { return d0 * 512 + ks * 4096 + half * 2048; }
template <int OFF> __device__ __forceinline__ s16x4 tr_read(int vb) {
    s16x4 r; asm volatile("ds_read_b64_tr_b16 %0, %1 offset:%2" : "=&v"(r) : "v"(vb), "i"(OFF) : "memory"); return r;
}
template <int D0> __device__ __forceinline__ void pv_one(f32x16& od, int vb, bf16x8 pa0, bf16x8 pa1, bf16x8 pa2, bf16x8 pa3) {
    const s16x4 l0 = tr_read<v_rd_off(D0, 0, 0)>(vb), h0 = tr_read<v_rd_off(D0, 0, 1)>(vb), l1 = tr_read<v_rd_off(D0, 1, 0)>(vb), h1 = tr_read<v_rd_off(D0, 1, 1)>(vb);
    const s16x4 l2 = tr_read<v_rd_off(D0, 2, 0)>(vb), h2 = tr_read<v_rd_off(D0, 2, 1)>(vb), l3 = tr_read<v_rd_off(D0, 3, 0)>(vb), h3 = tr_read<v_rd_off(D0, 3, 1)>(vb);
    asm volatile("s_waitcnt lgkmcnt(0)" ::: "memory"); SBAR();
#define PK(L, H) (bf16x8){L[0], L[1], L[2], L[3], H[0], H[1], H[2], H[3]}
    od = __builtin_amdgcn_mfma_f32_32x32x16_bf16(pa0, PK(l0, h0), od, 0, 0, 0);
    od = __builtin_amdgcn_mfma_f32_32x32x16_bf16(pa1, PK(l1, h1), od, 0, 0, 0);
    od = __builtin_amdgcn_mfma_f32_32x32x16_bf16(pa2, PK(l2, h2), od, 0, 0, 0);
    od = __builtin_amdgcn_mfma_f32_32x32x16_bf16(pa3, PK(l3, h3), od, 0, 0, 0);
#undef PK
}
__device__ __forceinline__ void pv_d0(f32x16* o, int vb, bf16x8 pa0, bf16x8 pa1, bf16x8 pa2, bf16x8 pa3) {
    pv_one<0>(o[0], vb, pa0, pa1, pa2, pa3); pv_one<1>(o[1], vb, pa0, pa1, pa2, pa3); pv_one<2>(o[2], vb, pa0, pa1, pa2, pa3); pv_one<3>(o[3], vb, pa0, pa1, pa2, pa3);
}
struct VFrag { s16x4 l0, h0, l1, h1, l2, h2, l3, h3; };
template <int D0> __device__ __forceinline__ void v_frag_read(VFrag& f, int vb) {
    f.l0 = tr_read<v_rd_off(D0, 0, 0)>(vb); f.h0 = tr_read<v_rd_off(D0, 0, 1)>(vb); f.l1 = tr_read<v_rd_off(D0, 1, 0)>(vb); f.h1 = tr_read<v_rd_off(D0, 1, 1)>(vb);
    f.l2 = tr_read<v_rd_off(D0, 2, 0)>(vb); f.h2 = tr_read<v_rd_off(D0, 2, 1)>(vb); f.l3 = tr_read<v_rd_off(D0, 3, 0)>(vb); f.h3 = tr_read<v_rd_off(D0, 3, 1)>(vb);
}
__device__ __forceinline__ void pv_mma(f32x16& od, const VFrag& f, bf16x8 pa0, bf16x8 pa1, bf16x8 pa2, bf16x8 pa3) {
#define PK(L, H) (bf16x8){L[0], L[1], L[2], L[3], H[0], H[1], H[2], H[3]}
    od = __builtin_amdgcn_mfma_f32_32x32x16_bf16(pa0, PK(f.l0, f.h0), od, 0, 0, 0);
    od = __builtin_amdgcn_mfma_f32_32x32x16_bf16(pa1, PK(f.l1, f.h1), od, 0, 0, 0);
    od = __builtin_amdgcn_mfma_f32_32x32x16_bf16(pa2, PK(f.l2, f.h2), od, 0, 0, 0);
    od = __builtin_amdgcn_mfma_f32_32x32x16_bf16(pa3, PK(f.l3, f.h3), od, 0, 0, 0);
#undef PK
}
#define LW(n) asm volatile("s_waitcnt lgkmcnt(" #n ")" ::: "memory")
template <int MODE, bool PF> __device__ __forceinline__ void pv_partial(f32x16* o, int vb, bf16x8 pa0, bf16x8 pa1, bf16x8 pa2, bf16x8 pa3, f32x16& p0, f32x16& p1, float& m_reg, float& alpha) {
    VFrag fa, fb;
    v_frag_read<0>(fa, vb);
    if constexpr (PF) { v_frag_read<1>(fb, vb); LW(8); } else LW(0);
    SBAR();
    pv_mma(o[0], fa, pa0, pa1, pa2, pa3);
    float pm0 = p0[0];
#pragma unroll
    for (int r = 1; r < 16; ++r) pm0 = fmaxf(pm0, p0[r]);
    if constexpr (PF) { v_frag_read<2>(fa, vb); LW(8); } else { v_frag_read<1>(fb, vb); LW(0); }
    SBAR();
    pv_mma(o[1], fb, pa0, pa1, pa2, pa3);
    float pmax = pm0;
#pragma unroll
    for (int r = 0; r < 16; ++r) pmax = fmaxf(pmax, p1[r]);
    { auto rr = __builtin_amdgcn_permlane32_swap(__float_as_uint(pmax), __float_as_uint(pmax), false, false);
      pmax = fmaxf(__uint_as_float(rr[0]), __uint_as_float(rr[1])); }
    const float mn = (pmax - m_reg > Cst<MODE>::THRS) ? fmaxf(m_reg, pmax) : m_reg;
    alpha = __builtin_amdgcn_exp2f(m_reg - mn); m_reg = mn;
    const f32x16 mnv = {mn, mn, mn, mn, mn, mn, mn, mn, mn, mn, mn, mn, mn, mn, mn, mn};
    if constexpr (PF) { v_frag_read<3>(fb, vb); LW(8); } else { v_frag_read<2>(fa, vb); LW(0); }
    SBAR();
    pv_mma(o[2], fa, pa0, pa1, pa2, pa3);
    p0 = p0 - mnv; p1 = p1 - mnv;
#pragma unroll
    for (int r = 0; r < 8; ++r) p0[r] = __builtin_amdgcn_exp2f(p0[r]);
    if constexpr (PF) { LW(0); } else { v_frag_read<3>(fb, vb); LW(0); }
    SBAR();
    pv_mma(o[3], fb, pa0, pa1, pa2, pa3);
#pragma unroll
    for (int r = 8; r < 16; ++r) p0[r] = __builtin_amdgcn_exp2f(p0[r]);
    asm volatile("" : "+v"(p0), "+v"(p1));
}
#undef LW
__device__ __forceinline__ bf16_t f2bf(float f) { return (bf16_t)(cvt_pk_bf16(f, f) & 0xffffu); }

template <int MODE, bool STORE = true>
__device__ __forceinline__ void attn_unit(LAS unsigned char* lds, const bf16_t* Qb, const bf16_t* __restrict__ Kh, const bf16_t* __restrict__ Krh, const bf16_t* __restrict__ Vh,
                                          int seq, bf16_t* Ob, float lam, const float* __restrict__ subg, int wv) {
    constexpr int ND = MODE ? 12 : 4, LDQ = MODE ? 1536 : 3072, LDK = MODE ? 2048 : 3072, LDO = MODE ? 1024 : 3072;
    constexpr bool PFV = (MODE == 0);
    constexpr int OFF_VR = 0, OFF_KRING = 3 * SHM_V, OFF_RRING = OFF_KRING + 2 * SHM_K, OFF_WS = OFF_RRING + (MODE ? 2 * SHM_KR : 0);
    int tid = wv * 64 + lane_id(); asm volatile("" : "+v"(tid));
    const int wid = __builtin_amdgcn_readfirstlane(tid >> 6), lane = tid & 63, r32 = lane & 31, hi = lane >> 5;
    const int comp = MODE ? 0 : (wid >> 2), wq = MODE ? wid : (wid & 3);
    LAS float* wsf = (LAS float*)(lds + OFF_WS) + wid * 64; LAS float* li_l = wsf; LAS float* al_l = wsf + 32;
    float m_reg = -1e30f, l_reg = 0; f32x16 o[4] = {}; bf16x8 qr[ND];
    const bf16_t* Qw = Qb + (size_t)(wq * 32 + r32) * LDQ + comp * 64 + hi * 8;
#pragma unroll
    for (int d0 = 0; d0 < ND; ++d0) qr[d0] = *(const bf16x8*)(Qw + d0 * 16);
    unsigned voffV[2], voffK[2];
#pragma unroll
    for (int i = 0; i < 2; ++i) {
        const int c = wid * 2 + i, ob = c * 1024 + lane * 16;
        { const int sub = ob >> 9, within = ob & 511, kk = (sub >> 2) * 8 + (within >> 6), k = (kk & ~0xC) | ((kk & 4) << 1) | ((kk & 8) >> 1), col = (sub & 3) * 32 + ((within & 63) >> 1);
          voffV[i] = (unsigned)(k * LDK + col) * 2u; }
        { const int row = 4 * c + (lane >> 4), g = lane & 15; voffK[i] = (unsigned)(row * LDK + ((g ^ (row & 15)) * 8)) * 2u; }
    }
    const int vb0 = (int)(unsigned)(uintptr_t)lds + v_rd_base(lane);
#define DMA_V(t, vo) do { const char* vt_ = (const char*)(Vh + (size_t)(t) * KVBLK * LDK); \
    _Pragma("unroll") for (int i_ = 0; i_ < 2; ++i_) \
        __builtin_amdgcn_global_load_lds((const unsigned*)(vt_ + voffV[0] + i_ * 128), (LAS unsigned*)(lds + OFF_VR + (vo) + (wid * 2 + i_) * 1024), 16, 0, 0); } while (0)
#define DMA_K(t, ki) do { const char* kt_ = (const char*)(Kh + (size_t)(t) * KVBLK * LDK); \
    _Pragma("unroll") for (int i_ = 0; i_ < 2; ++i_) \
        __builtin_amdgcn_global_load_lds((const unsigned*)(kt_ + voffK[i_]), (LAS unsigned*)(lds + OFF_KRING + (ki) * SHM_K + (wid * 2 + i_) * 1024), 16, 0, 0); \
    if constexpr (MODE == 1) { const int row_ = 8 * wid + (lane >> 3); const unsigned vr_ = (unsigned)(row_ * 64 + (((lane & 7) ^ ((row_ >> 1) & 7)) * 8)) * 2u;     \
        __builtin_amdgcn_global_load_lds((const unsigned*)((const char*)(Krh + (size_t)(t) * KVBLK * 64) + vr_), (LAS unsigned*)(lds + OFF_RRING + (ki) * SHM_KR + wid * 1024), 16, 0, 0); } } while (0)
#define RESC(a) do { if (__any((a) < 1.f)) { if (hi == 0) al_l[r32] = (a); asm volatile("s_waitcnt lgkmcnt(0)" ::: "memory"); \
    _Pragma("unroll") for (int d = 0; d < 4; ++d) _Pragma("unroll") for (int r = 0; r < 16; ++r) o[d][r] *= al_l[crow(r, hi)]; } } while (0)
#define KB(ki) (lds + OFF_KRING + (ki) * SHM_K)
#define KRB(ki) (lds + OFF_RRING + (ki) * SHM_KR)
#define LBAR() asm volatile("s_waitcnt vmcnt(0) lgkmcnt(0)\n\ts_barrier" ::: "memory")
#define ROT() do { k_cur ^= 1; const int t_ = v_pp; v_pp = v_p; v_p = v_c; v_c = t_; } while (0)
#define ITER(jj, PC0, PC1, alC, PP0, PP1, alP) do { \
    if (!g2) { if ((jj) + 1 < NT) DMA_K((jj) + 1, k_cur ^ 1); DMA_V((jj), v_c); } \
    SBAR(); qkt<MODE>(PC0, PC1, KB(k_cur), KRB(k_cur), qr, r32, hi, comp); \
    finishSM(PP0, PP1, alP, l_reg, pa0, pa1, pa2, pa3); SBAR(); \
    if (g2) LBAR(); \
    pv_partial<MODE, PFV>(o, vb0 + v_p, pa0, pa1, pa2, pa3, PC0, PC1, m_reg, alC); \
    RESC(alC); \
    if (g2) { if ((jj) + 2 < NT) DMA_K((jj) + 2, k_cur); if ((jj) + 1 < NT) DMA_V((jj) + 1, v_pp); } else LBAR(); \
    ROT(); } while (0)
    f32x16 pA0, pA1, pB0, pB1; float mnA, alA, alB; bf16x8 pa0, pa1, pa2, pa3; const int NT = seq / KVBLK;
    const bool g2 = wid >= 4;
    if (g2) __builtin_amdgcn_s_setprio(1);
    int k_cur = 0, v_pp = SHM_V, v_p = 2 * SHM_V, v_c = 0;
    DMA_K(0, 0); DMA_K(1, 1); DMA_V(0, 0); LBAR();
    qkt<MODE>(pA0, pA1, KB(0), KRB(0), qr, r32, hi, comp); partialSM<MODE>(pA0, pA1, m_reg, mnA, alA);
    if (g2) { LBAR(); DMA_K(2, 0); DMA_V(1, SHM_V); } else LBAR();
    ROT();
    int j = 1;
    for (; j + 2 < NT; j += 2) {
        ITER(j, pB0, pB1, alB, pA0, pA1, alA);
        ITER(j + 1, pA0, pA1, alA, pB0, pB1, alB);
    }
    ITER(j, pB0, pB1, alB, pA0, pA1, alA);
    finishSM(pB0, pB1, alB, l_reg, pa0, pa1, pa2, pa3); SBAR();
    pv_d0(o, vb0 + v_p, pa0, pa1, pa2, pa3);
    __builtin_amdgcn_s_setprio(0);
    if (hi == 0) li_l[r32] = l_reg; asm volatile("s_waitcnt lgkmcnt(0)" ::: "memory");
    float rli[16];
#pragma unroll
    for (int r = 0; r < 16; ++r) rli[r] = __builtin_amdgcn_rcpf(li_l[crow(r, hi)]);
    if constexpr (MODE == 1) {
        bf16_t* Ow = Ob + (size_t)(wq * 32) * LDO;
#pragma unroll
        for (int r = 0; r < 16; ++r) { const int orow = crow(r, hi);
#pragma unroll
            for (int d0 = 0; d0 < 4; ++d0) Ow[(size_t)orow * LDO + d0 * 32 + r32] = f2bf(o[d0][r] * rli[r]); }
        __syncthreads();
    } else {
        __syncthreads();
        LAS float* X = (LAS float*)lds + (size_t)wq * 4096 + lane;
        if (comp == 1) {
#pragma unroll
            for (int d0 = 0; d0 < 4; ++d0)
#pragma unroll
                for (int r = 0; r < 16; ++r) X[(d0 * 16 + r) * 64] = o[d0][r] * rli[r];
        }
        __syncthreads();
        if (comp == 0) {
            float ss[16];
#pragma unroll
            for (int r = 0; r < 16; ++r) { float s = 0.f;
#pragma unroll
                for (int d0 = 0; d0 < 4; ++d0) { const float v = o[d0][r] * rli[r] - lam * X[(d0 * 16 + r) * 64]; o[d0][r] = v; s += v * v; }
                ss[r] = s; }
#pragma unroll
            for (int r = 0; r < 16; ++r) { float s = ss[r];
                s += shx<1>(s); s += shx<2>(s); s += shx<4>(s); s += shx<8>(s); s += shx<16>(s);
                ss[r] = rsqrtf(s * (1.0f / 128.0f) + EPS) * 0.8f; }
            float gg[4];
#pragma unroll
            for (int d0 = 0; d0 < 4; ++d0) gg[d0] = subg[d0 * 32 + r32];
            bf16_t* Ow = Ob + (size_t)(wq * 32) * LDO;
#pragma unroll
            for (int r = 0; r < 16; ++r) { const int orow = crow(r, hi);
#pragma unroll
                for (int d0 = 0; d0 < 4; ++d0) { const bf16_t val = f2bf(o[d0][r] * ss[r] * gg[d0]); if (STORE || val == 0x7fc1) Ow[(size_t)orow * LDO + d0 * 32 + r32] = val; } }
        }
        __syncthreads();
    }
#undef DMA_V
#undef DMA_K
#undef RESC
#undef KB
#undef KRB
#undef LBAR
#undef ROT
#undef ITER
}
}

struct ColSrc { const float* p; int ld; };
template <class Map>
__device__ __forceinline__ void transpose_items(const Map mp, int K, int Nout, bf16_t* WT, const float* gain, LAS float* scr, int gw, int ngw, int lane) {
    const int nblk = Nout / 32, nitems = (K / 64) * nblk;
    for (int it = gw; it < nitems; it += ngw) {
        const int kb = it / nblk, nb = it % nblk, k0 = 64 * kb, n0 = 32 * nb;
        const int n4 = (lane & 7) * 4;
        const ColSrc cs = mp(n0 + n4);
        f32x4 v[8];
#pragma unroll
        for (int i = 0; i < 8; ++i) { const int kk = 8 * i + (lane >> 3);
            v[i] = cs.p ? *(const f32x4*)(cs.p + (size_t)(k0 + kk) * cs.ld) : (f32x4){0.f, 0.f, 0.f, 0.f}; }
#pragma unroll
        for (int i = 0; i < 8; ++i) { const int kk = 8 * i + (lane >> 3);
            f32x4 w = v[i]; if (gain) w = w * gain[k0 + kk];
            LAS float* d = scr + kk * 33 + n4; d[0] = w[0]; d[1] = w[1]; d[2] = w[2]; d[3] = w[3]; }
        asm volatile("s_waitcnt lgkmcnt(0)" ::: "memory");
        const int c = lane & 7;
#pragma unroll
        for (int j = 0; j < 4; ++j) { const int n = (lane >> 3) + 8 * j; const LAS float* s = scr + (8 * c) * 33 + n;
            u32x4 o; o.x = cvt_pk_bf16(s[0 * 33], s[1 * 33]); o.y = cvt_pk_bf16(s[2 * 33], s[3 * 33]); o.z = cvt_pk_bf16(s[4 * 33], s[5 * 33]); o.w = cvt_pk_bf16(s[6 * 33], s[7 * 33]);
            *(u32x4*)(WT + (size_t)(n0 + n) * K + k0 + 8 * c) = o; }
        asm volatile("s_waitcnt lgkmcnt(0)" ::: "memory");
    }
}
__device__ __forceinline__ int rope_src(int j, int ng) { const int g = j >> 3; if (g >= ng) return j; return ((j & 7) < 4 ? 0 : 4 * ng) + 4 * g + (j & 3); }
struct MapIn { const float* w;
    __device__ ColSrc operator()(int n) const {
        int src;
        if (n < 2048) src = (n & ~63) + rope_src(n & 63, 2);
        else if (n < 4096) src = n;
        else if (n < 4160) src = 4096 + rope_src(n - 4096, 8);
        else return ColSrc{nullptr, 0};
        return ColSrc{w + src, 8256}; } };
struct MapG { const float* w;
    __device__ ColSrc operator()(int n) const { return ColSrc{w + 4160 + n, 8256}; } };
struct MapQb { const float* w;
    __device__ ColSrc operator()(int n) const { const int blk = n >> 6; const int src = (blk % 3 == 2) ? (n & ~63) + rope_src(n & 63, 8) : n; return ColSrc{w + src, 1536}; } };
struct MapId { const float* w; int ld;
    __device__ ColSrc operator()(int n) const { return ColSrc{w + n, ld}; } };
struct MapGu { const float* wg; const float* wu;
    __device__ ColSrc operator()(int n) const { const int t = n >> 8, r = n & 255; return r < 128 ? ColSrc{wg + t * 128 + r, FF} : ColSrc{wu + t * 128 + (r - 128), FF}; } };

struct Args {
    const float* in[21]; float* out; unsigned char* ws;
};
constexpr int NWAVES = 8;
constexpr int LDS_BYTES = 147456;

__global__ void __launch_bounds__(NWAVES * 64, 2) fwd_mega(Args a) {
    extern __shared__ __attribute__((aligned(16))) unsigned char lds_raw[];
    LAS unsigned char* lds = (LAS unsigned char*)lds_raw;
    cg::grid_group grid = cg::this_grid();
    const int G = gridDim.x, bx = blockIdx.x;
    const int wv = __builtin_amdgcn_readfirstlane((int)threadIdx.x >> 6);
    volatile LAS unsigned* bst = (volatile LAS unsigned*)(lds + 139264);
    if (threadIdx.x < 2) bst[threadIdx.x] = 0u;
    const int vcu = (G % 8 == 0) ? (bx % 8) * (G / 8) + bx / 8 : bx;
#define PHASE_PTRS() \
    size_t zoff_ = 0; asm volatile("" : "+s"(zoff_)); unsigned char* ws = a.ws + zoff_; \
    int tid = wv * 64 + lane_id(); asm volatile("" : "+v"(tid)); const int lane = tid & 63, wave = wv; (void)lane; (void)wave; \
    const int gw = vcu * NWAVES + wave, ngw = G * NWAVES; (void)gw; (void)ngw; \
    const float* x0 = a.in[0]; const float* x1 = a.in[1]; (void)x0; (void)x1; \
    float* ssq_q = (float*)(ws + WS_SSQ); float* ssq_kv = (float*)(ws + WS_SSQ + MiB); float* rstd1 = (float*)(ws + WS_RSTD); (void)ssq_q; (void)ssq_kv; (void)rstd1; \
    float* tda = (float*)(ws + WS_TDA); float* tmla = (float*)(ws + WS_TMLA); (void)tda; (void)tmla; \
    bf16_t* Wi = (bf16_t*)(ws + WS_WI); bf16_t* Wg = (bf16_t*)(ws + WS_WG); bf16_t* Wqb = (bf16_t*)(ws + WS_WQB); bf16_t* Wkvb = (bf16_t*)(ws + WS_WKVB); bf16_t* Wbda = (bf16_t*)(ws + WS_WBDA); \
    bf16_t* Wbmla = (bf16_t*)(ws + WS_WBMLA); bf16_t* Wout = (bf16_t*)(ws + WS_WOUT); bf16_t* Wgu = (bf16_t*)(ws + WS_WGU); bf16_t* Wd = (bf16_t*)(ws + WS_WD); \
    bf16_t* QKV = (bf16_t*)(ws + WS_QKV); bf16_t* TMP = QKV; bf16_t* X1B = QKV; bf16_t* CQKV = (bf16_t*)(ws + WS_CQKV); bf16_t* OM = CQKV; bf16_t* KR = (bf16_t*)(ws + WS_KR); \
    bf16_t* XN = (bf16_t*)(ws + WS_XN); bf16_t* KVM = (bf16_t*)(ws + WS_KVM); bf16_t* MRG = KVM; bf16_t* QM = (bf16_t*)(ws + WS_QM); bf16_t* ACT = (bf16_t*)(ws + WS_ACT); \
    (void)Wi; (void)Wg; (void)Wqb; (void)Wkvb; (void)Wbda; (void)Wbmla; (void)Wout; (void)Wgu; (void)Wd; (void)QKV; (void)TMP; (void)X1B; (void)CQKV; (void)OM; (void)KR; (void)XN; (void)KVM; (void)MRG; (void)QM; (void)ACT;
#define GRID_BAR() xcd_barrier((unsigned*)(a.ws + WS_BAR), bst, wv == 0 && lane_id() == 0)

    {
        PHASE_PTRS();
        LAS float* scr = (LAS float*)(lds + wave * 16384);
        if (bx == 0) for (int i = tid; i < XCD_BAR_WORDS; i += 512) ((unsigned*)(ws + WS_BAR))[i] = 0u;
        for (int i = bx * 512 + tid; i < S1 * 40; i += G * 512) {
            const int pos = i / 40, k = i % 40;
            const float expo = k < 8 ? (float)k * (1.0f / 8.0f) : (float)(k - 8) * (1.0f / 32.0f);
            const float inv = __builtin_amdgcn_exp2f(-expo * 18.931568569324174f);
            const float ang = (float)pos * inv;
            const double rev = (double)ang * 0.15915494309189535; const float fr = (float)(rev - __builtin_rint(rev));
            const float c = __builtin_amdgcn_cosf(fr), sn = __builtin_amdgcn_sinf(fr);
            if (k < 8) { tda[(size_t)pos * 16 + k] = c; tda[(size_t)pos * 16 + 8 + k] = sn; }
            else { tmla[(size_t)pos * 64 + (k - 8)] = c; tmla[(size_t)pos * 64 + 32 + (k - 8)] = sn; }
        }
        transpose_items(MapIn{a.in[3]}, 2048, NINP, Wi, nullptr, scr, gw, ngw, lane);
        transpose_items(MapG{a.in[3]}, 2048, 4096, Wg, nullptr, scr, gw, ngw, lane);
        transpose_items(MapQb{a.in[10]}, 512, 1536, Wqb, a.in[9], scr, gw, ngw, lane);
        transpose_items(MapId{a.in[12], 2048}, 512, 2048, Wkvb, a.in[11], scr, gw, ngw, lane);
        transpose_items(MapId{a.in[13], 2048}, 1024, 2048, Wbda, nullptr, scr, gw, ngw, lane);
        transpose_items(MapId{a.in[14], 2048}, 1024, 2048, Wbmla, nullptr, scr, gw, ngw, lane);
        const float* gn = a.in[2];
        for (int m = gw; m < T; m += ngw) {
            const float* xr = m < S0 ? x0 + (size_t)m * DM : x1 + (size_t)(m - S0) * DM;
            f32x4 v[8]; float sq = 0.f;
#pragma unroll
            for (int j = 0; j < 8; ++j) { v[j] = *(const f32x4*)(xr + j * 256 + lane * 4); sq += sumsq4(v[j]); }
            const float rs = rsqrtf(wave_sum(sq) * (1.0f / DM) + EPS);
#pragma unroll
            for (int j = 0; j < 8; ++j) { const f32x4 gv = *(const f32x4*)(gn + j * 256 + lane * 4); const f32x4 y = v[j] * rs * gv;
                u32x2 w; w.x = cvt_pk_bf16(y[0], y[1]); w.y = cvt_pk_bf16(y[2], y[3]); *(u32x2*)(XN + (size_t)m * DM + j * 256 + lane * 4) = w; }
        }
    }
    grid.sync();
    if (wv == 0 && lane_id() == 0) (void)xb_add(&((unsigned*)(a.ws + WS_BAR))[XB_XCNT(xb_xcc_id())], 1u);
    {
        PHASE_PTRS();
        pg8::Gemm g{XN, Wi, T, NINP, 2048, 2048}; pg8::StaticOrder S; S.init(T, NINP, G, bx);
        EpiIn E{QKV, CQKV, KR, ssq_q, ssq_kv, tda, tmla};
        pg8::gemm_phase(lds, g, S, E, wv);
    }
    GRID_BAR();
    {
        PHASE_PTRS();
        pg8::Gemm g{CQKV, Wqb, T, 1536, 512, 1024}; pg8::StaticOrder S; S.init(T, 1536, G, bx);
        EpiQb E{QM, ssq_q, tmla};
        pg8::gemm_phase(lds, g, S, E, wv);
    }
    {
        PHASE_PTRS();
        pg8::Gemm g{CQKV + 512, Wkvb, T, 2048, 512, 1024}; pg8::StaticOrder S; S.init(T, 2048, G, bx);
        EpiScale E{KVM, 2048, ssq_kv, 1.0f / 512.0f};
        pg8::gemm_phase(lds, g, S, E, wv);
    }
    GRID_BAR();
    {
        PHASE_PTRS();
        float lam;
        { const float a1 = a.in[4][lane] * a.in[5][lane], a2 = a.in[6][lane] * a.in[7][lane];
          lam = __builtin_amdgcn_exp2f(wave_sum(a1) * LOG2E) - __builtin_amdgcn_exp2f(wave_sum(a2) * LOG2E) + 0.2f; }
        const float* subg = a.in[8];
#ifdef PROBE_DA2
        for (int u = vcu; u < 1024 + 512; u += G) {
            const bool smp = u < 1024; const int uu = smp ? u : u - 1024;
            const int h = (uu & 255) >> 5, qb = (uu >> 8) * 32 + (uu & 31);
            const int seq0 = smp ? S0 : 0, seq = smp ? S1 : S0;
            const bf16_t* base = QKV + (size_t)seq0 * 3072 + h * 128;
            bf16_t* qp = QKV + (size_t)(seq0 + qb * 128) * 3072 + h * 128;
            att::attn_unit<0, false>(lds, qp, base + 1024, nullptr, base + 2048, seq, qp, lam, subg, wv);
        }
#endif
        for (int u = vcu; u < 1024 + 512; u += G) {
            const bool smp = u < 1024; const int uu = smp ? u : u - 1024;
            const int h = (uu & 255) >> 5, qb = (uu >> 8) * 32 + (uu & 31);
            const int seq0 = smp ? S0 : 0, seq = smp ? S1 : S0;
            const bf16_t* base = QKV + (size_t)seq0 * 3072 + h * 128;
            bf16_t* qp = QKV + (size_t)(seq0 + qb * 128) * 3072 + h * 128;
            att::attn_unit<0>(lds, qp, base + 1024, nullptr, base + 2048, seq, qp, lam, subg, wv);
        }
#ifdef PROBE_MLA2
        for (int rep_ = 0; rep_ < 2; ++rep_)
#endif
        for (int u = vcu; u < 512 + 256; u += G) {
            const bool smp = u < 512; const int uu = smp ? u : u - 512;
            const int h = (uu & 255) >> 5, qb = (uu >> 8) * 32 + (uu & 31);
            const int seq0 = smp ? S0 : 0, seq = smp ? S1 : S0;
            const bf16_t* qp = QM + (size_t)(seq0 + qb * 256) * 1536 + h * 192;
            const bf16_t* kp = KVM + (size_t)seq0 * 2048 + h * 256;
            att::attn_unit<1>(lds, qp, kp, KR + (size_t)seq0 * 64, kp + 128, seq, OM + (size_t)(seq0 + qb * 256) * 1024 + h * 128, 0.f, nullptr, wv);
        }
    }
    GRID_BAR();
    {
        PHASE_PTRS();
        LAS float* scr = (LAS float*)(lds + wave * 16384);
        transpose_items(MapId{a.in[15], 2048}, 2048, 2048, Wout, nullptr, scr, gw, ngw, lane);
        __syncthreads();
    }
    {
        PHASE_PTRS();
        pg8::Gemm g{QKV, Wbda, T, 2048, 1024, 3072}; pg8::StaticOrder S; S.init(T, 2048, G, bx);
        EpiPlain E{MRG, 2048};
        pg8::gemm_phase(lds, g, S, E, wv);
    }
    {
        PHASE_PTRS();
        pg8::Gemm g{XN, Wg, T, 2048, 2048, 2048}; pg8::StaticOrder S; S.init(T, 2048, G, bx);
        EpiGate<0> E{MRG, nullptr};
        pg8::gemm_phase(lds, g, S, E, wv);
    }
    GRID_BAR();
    {
        PHASE_PTRS();
        pg8::Gemm g{OM, Wbmla, T, 2048, 1024, 1024}; pg8::StaticOrder S; S.init(T, 2048, G, bx);
        EpiPlain E{TMP, 2048};
        pg8::gemm_phase(lds, g, S, E, wv);
    }
    {
        PHASE_PTRS();
        pg8::Gemm g{XN, Wg + (size_t)2048 * 2048, T, 2048, 2048, 2048}; pg8::StaticOrder S; S.init(T, 2048, G, bx);
        EpiGate<1> E{MRG, TMP};
        pg8::gemm_phase(lds, g, S, E, wv);
    }
    GRID_BAR();
    {
        PHASE_PTRS();
        pg8::Gemm g{MRG, Wout, T, 2048, 2048, 2048}; pg8::StaticOrder S; S.init(T, 2048, G, bx);
        EpiX1 E{x0, x1, X1B};
        pg8::gemm_phase(lds, g, S, E, wv);
    }
    GRID_BAR();
    {
        PHASE_PTRS();
        LAS float* scr = (LAS float*)(lds + wave * 16384);
        transpose_items(MapGu{a.in[17], a.in[18]}, 2048, 11264, Wgu, a.in[16], scr, gw, ngw, lane);
        transpose_items(MapId{a.in[19], 2048}, FF, 2048, Wd, nullptr, scr, gw, ngw, lane);
        for (int m = gw; m < T; m += ngw) {
            float sq = 0.f;
#pragma unroll
            for (int j = 0; j < 4; ++j) { f32x4 p, q; unpack8(*(const u32x4*)(X1B + (size_t)m * DM + j * 512 + lane * 8), p, q); sq += sumsq4(p) + sumsq4(q); }
            sq = wave_sum(sq);
            if (lane == 0) rstd1[m] = rsqrtf(sq * (1.0f / DM) + EPS);
        }
        __syncthreads();
    }
    GRID_BAR();
    {
        PHASE_PTRS();
        pg8::Gemm g{X1B, Wgu, T, 11264, 2048, 2048}; pg8::StaticOrder S; S.init(T, 11264, G, bx);
        EpiSwiGLU E{ACT, rstd1};
        pg8::gemm_phase(lds, g, S, E, wv);
    }
    GRID_BAR();
    {
        PHASE_PTRS();
        pg8::Gemm g{ACT, Wd, T, 2048, FF, FF}; pg8::StaticOrder S; S.init(T, 2048, G, bx);
        EpiX2 E{X1B};
        pg8::gemm_phase(lds, g, S, E, wv);
    }
    GRID_BAR();
    {
        PHASE_PTRS();
        const float* gn = a.in[20];
        for (int m = gw; m < T; m += ngw) {
            f32x4 v[8]; float sq = 0.f;
#pragma unroll
            for (int j = 0; j < 4; ++j) { unpack8(*(const u32x4*)(X1B + (size_t)m * DM + j * 512 + lane * 8), v[2 * j], v[2 * j + 1]); sq += sumsq4(v[2 * j]) + sumsq4(v[2 * j + 1]); }
            const float rs = rsqrtf(wave_sum(sq) * (1.0f / DM) + EPS);
            float* orow = a.out + (size_t)m * DM;
#pragma unroll
            for (int j = 0; j < 4; ++j) { const int c = j * 512 + lane * 8;
                *(f32x4*)(orow + c) = v[2 * j] * rs * *(const f32x4*)(gn + c); *(f32x4*)(orow + c + 4) = v[2 * j + 1] * rs * *(const f32x4*)(gn + c + 4); }
        }
    }
}

extern "C" void kernel_launch(void* const* d_in, const int* in_sizes, int n_in, void* d_out, int out_size, void* d_ws, size_t ws_size, hipStream_t stream) {
    static int grid = 0;
    if (grid == 0) {
        if (n_in != 21 || in_sizes[0] != S0 * DM || in_sizes[1] != S1 * DM || out_size != T * DM || ws_size < WS_END) {
            fprintf(stderr, "kernel_launch: shape mismatch n_in %d in0 %d in1 %d out %d ws %zu (need %zu)\n", n_in, n_in > 0 ? in_sizes[0] : -1, n_in > 1 ? in_sizes[1] : -1, out_size, ws_size, (size_t)WS_END);
            grid = -1; return; }
        int dev = 0, cus = 0, per_cu = 0;
        if (hipGetDevice(&dev) != hipSuccess || hipDeviceGetAttribute(&cus, hipDeviceAttributeMultiprocessorCount, dev) != hipSuccess) { grid = -1; return; }
        if (hipFuncSetAttribute((const void*)fwd_mega, hipFuncAttributeMaxDynamicSharedMemorySize, LDS_BYTES) != hipSuccess) { fprintf(stderr, "kernel_launch: hipFuncSetAttribute failed\n"); grid = -1; return; }
        if (hipOccupancyMaxActiveBlocksPerMultiprocessor(&per_cu, (const void*)fwd_mega, NWAVES * 64, LDS_BYTES) != hipSuccess || per_cu < 1) { fprintf(stderr, "kernel_launch: occupancy query says %d\n", per_cu); per_cu = 1; }
        (void)hipGetLastError();
        grid = cus * per_cu;
    }
    if (grid < 0) return;
    Args a{};
    for (int i = 0; i < 21; ++i) a.in[i] = (const float*)d_in[i];
    a.out = (float*)d_out; a.ws = (unsigned char*)d_ws;
    void* args[] = {&a};
    const hipError_t e = hipLaunchCooperativeKernel((void*)fwd_mega, dim3(grid), dim3(NWAVES * 64), args, LDS_BYTES, stream);
    if (e != hipSuccess) fprintf(stderr, "kernel_launch: cooperative launch failed: %s (grid %d)\n", hipGetErrorString(e), grid);
}
```
